# Optimizing an MI355X kernel written in HIP

```python
import jax, jax.numpy as jnp
from jax import lax
import numpy as np

D_MODEL = 2048
BATCH = 32
SEQ = 256
DEPTH = 4
DEC_BATCH = 4
DEC_SEQ = 1024
PAST_LEN = 256

GRID_W = 64
N_MIXERS = 3
N_ATTN = (DEPTH + 2) // 3
N_MLSTM = (DEPTH + 1) // 3
N_RWKV = DEPTH // 3
N_MOD = 9
D_FF = 5632
EPS = 1e-6

ATTN_HEADS = 16
ATTN_KV_HEADS = 4
ATTN_GROUP = ATTN_HEADS // ATTN_KV_HEADS
ATTN_HEAD_DIM = D_MODEL // ATTN_HEADS
ATTN_WINDOW = 128
ATTN_BLOCK = 128
ROPE_THETA = 10000.0
QKV_DIM = (ATTN_HEADS + 2 * ATTN_KV_HEADS) * ATTN_HEAD_DIM

MLSTM_HEADS = 8
MLSTM_DV = D_MODEL // MLSTM_HEADS
MLSTM_DK = MLSTM_DV // 2
MLSTM_CHUNK = 64
MLSTM_IN_DIM = 2 * MLSTM_HEADS * MLSTM_DK + 2 * D_MODEL

RWKV_HEAD = 64
RWKV_HEADS = D_MODEL // RWKV_HEAD
RWKV_LORA_W = 96
RWKV_LORA_A = 96
RWKV_LORA_G = 256
RWKV_GN_EPS = 64e-5

kernel_name = 'hybrid_dit_attn_mlstm_rwkv7_step'


def rmsnorm(x, g, eps=EPS):
    xf = x.astype(jnp.float32)
    y = xf * lax.rsqrt(jnp.mean(xf * xf, axis=-1, keepdims=True) + eps)
    return (y * g.astype(jnp.float32)).astype(x.dtype)


def modulate(x, g, shift, scale):
    return rmsnorm(x, g) * (1.0 + scale) + shift


def swiglu(h, w_in, w_out):
    gate, up = jnp.split(h @ w_in, 2, axis=-1)
    return (jax.nn.silu(gate) * up) @ w_out


def adaln(cond, mod_w, mod_b):
    m = jax.nn.silu(cond) @ mod_w + mod_b
    return m.reshape(cond.shape[0], N_MOD, D_MODEL)


def macaron_layer(x, mod, norm_g, ffn_w_in, ffn_w_out, mixer):
    m = lambda j: mod[:, None, j, :]
    x = x + 0.5 * m(2) * swiglu(modulate(x, norm_g[0], m(0), m(1)), ffn_w_in[0], ffn_w_out[0])
    y, st = mixer(modulate(x, norm_g[1], m(3), m(4)))
    x = x + m(5) * y
    x = x + 0.5 * m(8) * swiglu(modulate(x, norm_g[2], m(6), m(7)), ffn_w_in[1], ffn_w_out[1])
    return x, st


def _rotate(x, ang):
    f = ang.shape[-1]
    cos = jnp.cos(ang)[:, None, :].astype(x.dtype)
    sin = jnp.sin(ang)[:, None, :].astype(x.dtype)
    xa, xb = x[..., :f], x[..., f:]
    return jnp.concatenate([xa * cos - xb * sin, xb * cos + xa * sin], axis=-1)


def rope_2d(x):
    n_tok = x.shape[1]
    rows = n_tok // GRID_W
    row = jnp.repeat(jnp.arange(rows, dtype=jnp.float32), GRID_W)
    col = jnp.tile(jnp.arange(GRID_W, dtype=jnp.float32), rows)
    n_freq = ATTN_HEAD_DIM // 4
    inv_freq = ROPE_THETA ** (-jnp.arange(n_freq, dtype=jnp.float32) / n_freq)
    half = ATTN_HEAD_DIM // 2
    return jnp.concatenate([_rotate(x[..., :half], row[:, None] * inv_freq),
                            _rotate(x[..., half:], col[:, None] * inv_freq)], axis=-1)


def attn_qkv(h, w_qkv, q_norm, k_norm):
    b, t, _ = h.shape
    q, k, v = jnp.split(h @ w_qkv, [ATTN_HEADS * ATTN_HEAD_DIM, (ATTN_HEADS + ATTN_KV_HEADS) * ATTN_HEAD_DIM], axis=-1)
    q = rmsnorm(q.reshape(b, t, ATTN_HEADS, ATTN_HEAD_DIM), q_norm)
    k = rmsnorm(k.reshape(b, t, ATTN_KV_HEADS, ATTN_HEAD_DIM), k_norm)
    v = v.reshape(b, t, ATTN_KV_HEADS, ATTN_HEAD_DIM)
    return q, k, v


def sink_attend(q, k, v, valid, sink):
    s = jnp.einsum('bqhgd,bshd->bhgqs', q.astype(jnp.float32), k.astype(jnp.float32)) * ATTN_HEAD_DIM ** -0.5
    if valid is not None:
        s = jnp.where(valid, s, -jnp.inf)
    sk = jnp.broadcast_to(sink.astype(jnp.float32).reshape(1, ATTN_KV_HEADS, ATTN_GROUP, 1, 1), s.shape[:-1] + (1,))
    p = jax.nn.softmax(jnp.concatenate([s, sk], axis=-1), axis=-1)[..., :-1]
    return jnp.einsum('bhgqs,bshd->bqhgd', p.astype(v.dtype), v)


def attn_context(h, w_qkv, q_norm, k_norm, sink, w_o):
    b, t, _ = h.shape
    q, k, v = attn_qkv(h, w_qkv, q_norm, k_norm)
    nb = t // ATTN_BLOCK
    qb = q.reshape(b, nb, ATTN_BLOCK, ATTN_KV_HEADS, ATTN_GROUP, ATTN_HEAD_DIM).swapaxes(0, 1)
    o = lax.map(lambda qblk: sink_attend(qblk, k, v, None, sink), qb)
    o = o.swapaxes(0, 1).reshape(b, t, ATTN_HEADS * ATTN_HEAD_DIM)
    return o @ w_o, (k, v)


def attn_latent(h, ctx_k, ctx_v, w_qkv, q_norm, k_norm, sink, w_o):
    b, t, _ = h.shape
    q, k, v = attn_qkv(h, w_qkv, q_norm, k_norm)
    q, k = rope_2d(q), rope_2d(k)
    span = ATTN_BLOCK + 2 * ATTN_WINDOW
    pad = ((0, 0), (ATTN_WINDOW, ATTN_WINDOW), (0, 0), (0, 0))
    k_pad, v_pad = jnp.pad(k, pad), jnp.pad(v, pad)
    ctx_k = ctx_k.astype(k.dtype)
    ctx_v = ctx_v.astype(v.dtype)
    n_ctx = ctx_k.shape[1]
    q_idx = jnp.arange(ATTN_BLOCK)[:, None]
    k_idx = jnp.arange(span)[None, :]
    in_window = jnp.abs(k_idx - ATTN_WINDOW - q_idx) <= ATTN_WINDOW
    ctx_valid = jnp.ones((ATTN_BLOCK, n_ctx), dtype=bool)

    def block(args):
        qblk, blk = args
        start = blk * ATTN_BLOCK
        kb = lax.dynamic_slice_in_dim(k_pad, start, span, axis=1)
        vb = lax.dynamic_slice_in_dim(v_pad, start, span, axis=1)
        key_pos = start - ATTN_WINDOW + k_idx
        valid = in_window & (key_pos >= 0) & (key_pos < t)
        valid = jnp.concatenate([valid, ctx_valid], axis=-1)
        return sink_attend(qblk, jnp.concatenate([kb, ctx_k], axis=1), jnp.concatenate([vb, ctx_v], axis=1), valid, sink)

    nb = t // ATTN_BLOCK
    qb = q.reshape(b, nb, ATTN_BLOCK, ATTN_KV_HEADS, ATTN_GROUP, ATTN_HEAD_DIM).swapaxes(0, 1)
    o = lax.map(block, (qb, jnp.arange(nb)))
    o = o.swapaxes(0, 1).reshape(b, t, ATTN_HEADS * ATTN_HEAD_DIM)
    return o @ w_o, None


def mlstm_chunkwise(q, k, v, i_pre, f_pre, c0, n0, m0):
    b, nh, t, _ = q.shape
    L = MLSTM_CHUNK
    nc = t // L

    def chunks(x):
        return jnp.moveaxis(x.reshape(x.shape[:2] + (nc, L) + x.shape[3:]), 2, 0)

    causal = jnp.tril(jnp.ones((L, L), dtype=bool))

    def step(carry, inp):
        C, n, m = carry
        qc, kc, vc, ic, lfc = inp
        bcum = jnp.cumsum(lfc, axis=-1)
        d = jnp.where(causal, bcum[..., :, None] - bcum[..., None, :] + ic[..., None, :], -jnp.inf)
        inter = bcum + m[..., None]
        m_c = jnp.maximum(inter, jnp.max(d, axis=-1))
        s = jnp.einsum('bhtd,bhsd->bhts', qc, kc) * jnp.exp(d - m_c[..., None])
        a = jnp.exp(inter - m_c)
        num = jnp.einsum('bhts,bhsv->bhtv', s, vc) + a[..., None] * jnp.einsum('bhtd,bhdv->bhtv', qc, C)
        den = jnp.sum(s, axis=-1) + a * jnp.einsum('bhtd,bhd->bht', qc, n)
        hc = num / jnp.maximum(jnp.abs(den), jnp.exp(-m_c))[..., None]
        bl = bcum[..., -1]
        g = bl[..., None] - bcum + ic
        m_new = jnp.maximum(bl + m, jnp.max(g, axis=-1))
        decay = jnp.exp(bl + m - m_new)
        wg = jnp.exp(g - m_new[..., None])
        C_new = decay[..., None, None] * C + jnp.einsum('bhs,bhsd,bhsv->bhdv', wg, kc, vc)
        n_new = decay[..., None] * n + jnp.einsum('bhs,bhsd->bhd', wg, kc)
        return (C_new, n_new, m_new), hc

    lf = jax.nn.log_sigmoid(f_pre)
    (C, n, m), h = lax.scan(step, (c0, n0, m0), (chunks(q), chunks(k), chunks(v), chunks(i_pre), chunks(lf)))
    h = jnp.moveaxis(h, 0, 2).reshape(b, nh, t, -1)
    return h, C, n, m


def mlstm_mixer(h, state0, w_in, w_gate, b_gate, out_norm, w_o):
    b, t, _ = h.shape
    f32 = jnp.float32
    qk = MLSTM_HEADS * MLSTM_DK
    q, k, v, og = jnp.split(h @ w_in, [qk, 2 * qk, 2 * qk + D_MODEL], axis=-1)

    def heads(x, d):
        return x.reshape(b, t, MLSTM_HEADS, d).transpose(0, 2, 1, 3).astype(f32)

    q = heads(q, MLSTM_DK) * MLSTM_DK ** -0.5
    k = heads(k, MLSTM_DK)
    v = heads(v, MLSTM_DV)
    gates = (h @ w_gate + b_gate).astype(f32).reshape(b, t, 4, MLSTM_HEADS).transpose(2, 0, 3, 1)
    c0, n0, m0 = [s.astype(f32) for s in state0]
    h_f, cf, nf, mf = mlstm_chunkwise(q, k, v, gates[0], gates[1], c0[:, 0], n0[:, 0], m0[:, 0])
    flip = lambda x: jnp.flip(x, axis=2)
    h_b, cb, nbk, mb = mlstm_chunkwise(flip(q), flip(k), flip(v), flip(gates[2]), flip(gates[3]), c0[:, 1], n0[:, 1], m0[:, 1])
    hs = rmsnorm(h_f + flip(h_b), out_norm.reshape(MLSTM_HEADS, 1, MLSTM_DV))
    hs = hs.transpose(0, 2, 1, 3).reshape(b, t, D_MODEL)
    y = (jax.nn.sigmoid(og.astype(f32)) * hs).astype(h.dtype) @ w_o
    return y, (jnp.stack([cf, cb], axis=1), jnp.stack([nf, nbk], axis=1), jnp.stack([mf, mb], axis=1))


def centred_shift(x):
    prev = jnp.pad(x[:, :-1], ((0, 0), (1, 0), (0, 0)))
    nxt = jnp.pad(x[:, 1:], ((0, 0), (0, 1), (0, 0)))
    return 0.5 * (prev + nxt) - x


def rwkv_scan(s0, r, w, k, v, kk, a, reverse):
    def step(S, inp):
        rt, wt, kt, vt, kkt, at = inp
        sa = jnp.einsum('bhvk,bhk->bhv', S, kkt)
        S = S * wt[:, :, None, :] - sa[..., None] * (kkt * at)[:, :, None, :] + vt[..., None] * kt[:, :, None, :]
        return S, jnp.einsum('bhvk,bhk->bhv', S, rt)
    return lax.scan(step, s0, (r, w, k, v, kk, a), reverse=reverse)


def rwkv_mixer(h, s0, mu, w_rkv, w0, wA, wB, a0, aA, aB, gA, gB, k_k, k_a, r_k, ln_g, ln_b, w_o):
    b, t, d = h.shape
    f32 = jnp.float32
    xs = h[None] + centred_shift(h)[None] * mu[:, None, None, :]
    r, k, v = jnp.einsum('pbtd,pde->pbte', xs[:3], w_rkv)
    lw = jnp.einsum('zbtr,zrd->zbtd', jnp.tanh(jnp.einsum('btd,zdr->zbtr', xs[3], wA)), wB)
    w_par = (w0[:, None, None, :] + lw).astype(f32)
    decay = jnp.exp(-jnp.exp(-jax.nn.softplus(-w_par) - 0.5))
    a = jax.nn.sigmoid((a0[:, None, None, :] + jnp.einsum('zbtr,zrd->zbtd', jnp.einsum('btd,zdr->zbtr', xs[4], aA), aB)).astype(f32))
    g = jax.nn.sigmoid(xs[5] @ gA) @ gB
    r, k, v = r.astype(f32), k.astype(f32), v.astype(f32)
    kkh = (k * k_k.astype(f32)).reshape(b, t, RWKV_HEADS, RWKV_HEAD)
    kkh = kkh / jnp.maximum(jnp.linalg.norm(kkh, axis=-1, keepdims=True), 1e-12)
    k_dir = k[None] * (1.0 + (a - 1.0) * k_a.astype(f32))
    tm = lambda x: x.reshape(b, t, RWKV_HEADS, RWKV_HEAD).swapaxes(0, 1)
    s0 = s0.astype(f32)
    kk_t = kkh.swapaxes(0, 1)
    s_f, y_f = rwkv_scan(s0[:, 0], tm(r), tm(decay[0]), tm(k_dir[0]), tm(v), kk_t, tm(a[0]), False)
    s_b, y_b = rwkv_scan(s0[:, 1], tm(r), tm(decay[1]), tm(k_dir[1]), tm(v), kk_t, tm(a[1]), True)
    y = (y_f + y_b).swapaxes(0, 1)
    mean = jnp.mean(y, axis=-1, keepdims=True)
    var = jnp.mean(jnp.square(y - mean), axis=-1, keepdims=True)
    y = (y - mean) * lax.rsqrt(var + RWKV_GN_EPS) * ln_g.astype(f32).reshape(RWKV_HEADS, RWKV_HEAD) + ln_b.astype(f32).reshape(RWKV_HEADS, RWKV_HEAD)
    rh = r.reshape(b, t, RWKV_HEADS, RWKV_HEAD)
    kd = k_dir.reshape(2, b, t, RWKV_HEADS, RWKV_HEAD)
    bonus = jnp.sum(rh[None] * kd * r_k.astype(f32), axis=(0, -1))[..., None] * v.reshape(b, t, RWKV_HEADS, RWKV_HEAD)
    y = ((y + bonus).reshape(b, t, d) * g.astype(f32)).astype(h.dtype)
    return y @ w_o, jnp.stack([s_f, s_b], axis=1)


def setup_inputs(seed: int = 0) -> dict:
    key = jax.random.key(seed)
    ks = iter(jax.random.split(key, 48))
    D = D_MODEL

    def nrm(shape, scale=1.0):
        return jax.random.normal(next(ks), shape, jnp.float32) * scale

    inp = {}
    inp['x_prompt'] = nrm((BATCH, SEQ, D))
    inp['x_sample'] = nrm((DEC_BATCH, DEC_SEQ, D))
    inp['cache_k'] = nrm((DEC_BATCH, N_ATTN, PAST_LEN, ATTN_KV_HEADS, ATTN_HEAD_DIM))
    inp['cache_v'] = nrm((DEC_BATCH, N_ATTN, PAST_LEN, ATTN_KV_HEADS, ATTN_HEAD_DIM))
    inp['state_mlstm_C'] = nrm((DEC_BATCH, N_MLSTM, 2, MLSTM_HEADS, MLSTM_DK, MLSTM_DV), 0.1)
    inp['state_mlstm_n'] = nrm((DEC_BATCH, N_MLSTM, 2, MLSTM_HEADS, MLSTM_DK), 0.1)
    inp['state_mlstm_m'] = nrm((DEC_BATCH, N_MLSTM, 2, MLSTM_HEADS))
    inp['state_rwkv'] = nrm((DEC_BATCH, N_RWKV, 2, RWKV_HEADS, RWKV_HEAD, RWKV_HEAD), 0.1)
    inp['c'] = nrm((DEC_BATCH, D))
    inp['c_ctx'] = nrm((D,))
    inp['mod_w'] = nrm((DEPTH, D, N_MOD * D), 0.5 * D ** -0.5)
    inp['mod_b'] = nrm((DEPTH, N_MOD * D), 0.02)
    inp['norm_g'] = 1.0 + nrm((DEPTH, 3, D), 0.02)
    inp['ffn_w_in'] = nrm((DEPTH, 2, D, 2 * D_FF), D ** -0.5)
    inp['ffn_w_out'] = nrm((DEPTH, 2, D_FF, D), D_FF ** -0.5)
    inp['attn_w_qkv'] = nrm((N_ATTN, D, QKV_DIM), D ** -0.5)
    inp['attn_q_norm'] = 1.0 + nrm((N_ATTN, ATTN_HEAD_DIM), 0.02)
    inp['attn_k_norm'] = 1.0 + nrm((N_ATTN, ATTN_HEAD_DIM), 0.02)
    inp['attn_sink'] = nrm((N_ATTN, ATTN_HEADS), 0.5)
    inp['attn_w_o'] = nrm((N_ATTN, ATTN_HEADS * ATTN_HEAD_DIM, D), (ATTN_HEADS * ATTN_HEAD_DIM) ** -0.5)
    inp['mlstm_w_in'] = nrm((N_MLSTM, D, MLSTM_IN_DIM), D ** -0.5)
    inp['mlstm_w_gate'] = nrm((N_MLSTM, D, 4 * MLSTM_HEADS), D ** -0.5)
    gate_base = jnp.tile(jnp.array([0.0, 3.0, 0.0, 3.0], jnp.float32)[:, None], (1, MLSTM_HEADS)).reshape(-1)
    inp['mlstm_b_gate'] = gate_base[None, :] + nrm((N_MLSTM, 4 * MLSTM_HEADS), 0.1)
    inp['mlstm_out_norm'] = 1.0 + nrm((N_MLSTM, D), 0.02)
    inp['mlstm_w_o'] = nrm((N_MLSTM, D, D), D ** -0.5)
    inp['rwkv_mu'] = jax.random.uniform(next(ks), (N_RWKV, 6, D), jnp.float32)
    inp['rwkv_w_rkv'] = nrm((N_RWKV, 3, D, D), D ** -0.5)
    inp['rwkv_w0'] = nrm((N_RWKV, 2, D), 0.5)
    inp['rwkv_wA'] = nrm((N_RWKV, 2, D, RWKV_LORA_W), D ** -0.5)
    inp['rwkv_wB'] = nrm((N_RWKV, 2, RWKV_LORA_W, D), 0.5 * RWKV_LORA_W ** -0.5)
    inp['rwkv_a0'] = nrm((N_RWKV, 2, D), 0.5)
    inp['rwkv_aA'] = nrm((N_RWKV, 2, D, RWKV_LORA_A), D ** -0.5)
    inp['rwkv_aB'] = nrm((N_RWKV, 2, RWKV_LORA_A, D), 0.5 * RWKV_LORA_A ** -0.5)
    inp['rwkv_gA'] = nrm((N_RWKV, D, RWKV_LORA_G), D ** -0.5)
    inp['rwkv_gB'] = nrm((N_RWKV, RWKV_LORA_G, D), RWKV_LORA_G ** -0.5)
    inp['rwkv_k_k'] = 0.85 + nrm((N_RWKV, D), 0.05)
    inp['rwkv_k_a'] = 1.0 + nrm((N_RWKV, D), 0.05)
    inp['rwkv_r_k'] = nrm((N_RWKV, RWKV_HEADS, RWKV_HEAD), 0.1)
    inp['rwkv_ln_g'] = 1.0 + nrm((N_RWKV, D), 0.02)
    inp['rwkv_ln_b'] = nrm((N_RWKV, D), 0.02)
    inp['rwkv_w_o'] = nrm((N_RWKV, D, D), D ** -0.5)
    return inp


def reference(x_prompt, x_sample, cache_k, cache_v, state_mlstm_C, state_mlstm_n, state_mlstm_m, state_rwkv,
              c, c_ctx, mod_w, mod_b, norm_g, ffn_w_in, ffn_w_out,
              attn_w_qkv, attn_q_norm, attn_k_norm, attn_sink, attn_w_o,
              mlstm_w_in, mlstm_w_gate, mlstm_b_gate, mlstm_out_norm, mlstm_w_o,
              rwkv_mu, rwkv_w_rkv, rwkv_w0, rwkv_wA, rwkv_wB, rwkv_a0, rwkv_aA, rwkv_aB,
              rwkv_gA, rwkv_gB, rwkv_k_k, rwkv_k_a, rwkv_r_k, rwkv_ln_g, rwkv_ln_b, rwkv_w_o):
    xc = x_prompt
    xl = x_sample
    b_ctx = x_prompt.shape[0]
    new_k, new_v, new_C, new_n, new_m, new_S = [], [], [], [], [], []
    for i in range(DEPTH):
        kind, slot = i % N_MIXERS, i // N_MIXERS
        mod_ctx = adaln(c_ctx[None, :], mod_w[i], mod_b[i])
        mod_lat = adaln(c, mod_w[i], mod_b[i])
        lp = (norm_g[i], ffn_w_in[i], ffn_w_out[i])
        if kind == 0:
            ap = (attn_w_qkv[slot], attn_q_norm[slot], attn_k_norm[slot], attn_sink[slot], attn_w_o[slot])
            xc, (k_ctx, v_ctx) = macaron_layer(xc, mod_ctx, *lp, lambda h: attn_context(h, *ap))
            xl, _ = macaron_layer(xl, mod_lat, *lp, lambda h: attn_latent(h, cache_k[:, slot], cache_v[:, slot], *ap))
            new_k.append(k_ctx)
            new_v.append(v_ctx)
        elif kind == 1:
            mp = (mlstm_w_in[slot], mlstm_w_gate[slot], mlstm_b_gate[slot], mlstm_out_norm[slot], mlstm_w_o[slot])
            zero_state = (jnp.zeros((b_ctx, 2, MLSTM_HEADS, MLSTM_DK, MLSTM_DV), jnp.float32),
                          jnp.zeros((b_ctx, 2, MLSTM_HEADS, MLSTM_DK), jnp.float32),
                          jnp.zeros((b_ctx, 2, MLSTM_HEADS), jnp.float32))
            lat_state = (state_mlstm_C[:, slot], state_mlstm_n[:, slot], state_mlstm_m[:, slot])
            xc, (C_ctx, n_ctx, m_ctx) = macaron_layer(xc, mod_ctx, *lp, lambda h: mlstm_mixer(h, zero_state, *mp))
            xl, _ = macaron_layer(xl, mod_lat, *lp, lambda h: mlstm_mixer(h, lat_state, *mp))
            new_C.append(C_ctx)
            new_n.append(n_ctx)
            new_m.append(m_ctx)
        else:
            rp = (rwkv_mu[slot], rwkv_w_rkv[slot], rwkv_w0[slot], rwkv_wA[slot], rwkv_wB[slot], rwkv_a0[slot],
                  rwkv_aA[slot], rwkv_aB[slot], rwkv_gA[slot], rwkv_gB[slot], rwkv_k_k[slot], rwkv_k_a[slot],
                  rwkv_r_k[slot], rwkv_ln_g[slot], rwkv_ln_b[slot], rwkv_w_o[slot])
            zero_s = jnp.zeros((b_ctx, 2, RWKV_HEADS, RWKV_HEAD, RWKV_HEAD), jnp.float32)
            xc, S_ctx = macaron_layer(xc, mod_ctx, *lp, lambda h: rwkv_mixer(h, zero_s, *rp))
            xl, _ = macaron_layer(xl, mod_lat, *lp, lambda h: rwkv_mixer(h, state_rwkv[:, slot], *rp))
            new_S.append(S_ctx)
    new_cache_k = jnp.stack(new_k, axis=1)
    new_cache_v = jnp.stack(new_v, axis=1)
    new_state_mlstm_C = jnp.stack(new_C, axis=1)
    new_state_mlstm_n = jnp.stack(new_n, axis=1)
    new_state_mlstm_m = jnp.stack(new_m, axis=1)
    new_state_rwkv = jnp.stack(new_S, axis=1)
    return (xc, xl, new_cache_k, new_cache_v, new_state_mlstm_C, new_state_mlstm_n, new_state_mlstm_m, new_state_rwkv)
```

```cpp
#ifndef HIPEMU
#include <hip/hip_runtime.h>
#endif
#include <cstdio>

#define DI __device__ __forceinline__
#ifdef HIPEMU
#define LAS
#define GAS
DI unsigned __float_as_uint(float f) { unsigned u; memcpy(&u, &f, 4); return u; }
DI float __uint_as_float(unsigned u) { float f; memcpy(&f, &u, 4); return f; }
#define NT_LD(p) (*(p))
#define NT_ST(p, v) (*(p) = (v))
#define WSYNC() do { emu::wave_bar(); } while (0)
#define VM_WAIT() do { } while (0)
#define SCHED_FENCE() do { } while (0)
#define CFENCE() do { } while (0)
#else
#define LAS __attribute__((address_space(3)))
#define GAS __attribute__((address_space(1)))
#define NT_LD(p) __builtin_nontemporal_load(p)
#define NT_ST(p, v) __builtin_nontemporal_store((v), (p))
#define WSYNC() do { asm volatile("s_waitcnt lgkmcnt(0)" ::: "memory"); __builtin_amdgcn_wave_barrier(); } while (0)
#define VM_WAIT() asm volatile("s_waitcnt vmcnt(0)" ::: "memory")
#define SCHED_FENCE() __builtin_amdgcn_sched_barrier(0)
#define CFENCE() asm volatile("" ::: "memory")
#endif

#ifdef CFG_SMALL
constexpr int D = 512, BC = 2, TC = 128, BL = 2, TL = 256, PAST = 128, DFF = 512, AH = 4, AKV = 1, MH = 2;
#else
constexpr int D = 2048, BC = 32, TC = 256, BL = 4, TL = 1024, PAST = 256, DFF = 5632, AH = 16, AKV = 4, MH = 8;
#endif
constexpr int DEPTH = 4, NMOD = 9, GRIDW = 64, HD = 128, AG = AH / AKV, QKVD = (AH + 2 * AKV) * HD, NSLOT_ATTN = 2;
constexpr int MDV = D / MH, MDK = MDV / 2, MIN = 2 * MH * MDK + 2 * D, MING = MIN + 256, NGATE = 4 * MH;
constexpr int RH = D / 64, LW = 96, LA = 96, LG = 256;
constexpr int MC = BC * TC, ML = BL * TL, M = MC + ML, NM = M / 256, NCOND = 1 + BL;
constexpr float EPS = 1e-6f, GN_EPS = 64e-5f;
static_assert(D / AH == HD && MDV == 256 && MDK == 128 && MC % 256 == 0 && TL % 256 == 0 && DFF % 128 == 0 && D % 256 == 0 && PAST % 64 == 0 && TC % 64 == 0, "shape assumptions");

enum { I_XP = 0, I_XS, I_CK, I_CV, I_MC, I_MN, I_MM, I_RS, I_C, I_CCTX, I_MODW, I_MODB, I_NORMG, I_FWI, I_FWO, I_AQKV, I_AQN, I_AKN, I_ASINK, I_AWO,
       I_MWI, I_MWG, I_MBG, I_MON, I_MWO, I_RMU, I_RWRKV, I_RW0, I_RWA, I_RWB, I_RA0, I_RAA, I_RAB, I_RGA, I_RGB, I_RKK, I_RKA, I_RRK, I_RLNG, I_RLNB, I_RWO, N_IN };
constexpr size_t O_Y = 0, O_CK = (size_t)M * D, CKN = (size_t)BC * NSLOT_ATTN * TC * AKV * HD, O_CV = O_CK + CKN, O_MC = O_CV + CKN,
                 O_MN = O_MC + (size_t)BC * 2 * MH * MDK * MDV, O_MM = O_MN + (size_t)BC * 2 * MH * MDK, O_RS = O_MM + (size_t)BC * 2 * MH, O_END = O_RS + (size_t)BC * 2 * RH * 64 * 64;

constexpr size_t al256(size_t x) { return (x + 255) & ~(size_t)255; }
constexpr size_t WS_CTL = 0, CTL_ZERO_BYTES = 1u << 20;
constexpr size_t WS_MOD = CTL_ZERO_BYTES, WS_ROPE = WS_MOD + al256((size_t)DEPTH * NCOND * NMOD * D * 4);
constexpr size_t WS_WFI = WS_ROPE + al256(64 * 32 * 2 * 4), SZ_WFI = (size_t)2 * DFF * D * 2;
constexpr size_t WS_WFO = WS_WFI + 8 * SZ_WFI, SZ_WFO = (size_t)D * DFF * 2;
constexpr size_t WS_WQKV = WS_WFO + 8 * SZ_WFO, SZ_WQKV = (size_t)QKVD * D * 2;
constexpr size_t WS_WAO = WS_WQKV + 2 * SZ_WQKV, SZ_WDD = (size_t)D * D * 2;
constexpr size_t WS_WMI = WS_WAO + 2 * SZ_WDD;
constexpr size_t WS_WMO = WS_WMI + (size_t)MING * D * 2;
constexpr size_t WS_WRK = WS_WMO + SZ_WDD;
constexpr size_t WS_WLB = WS_WRK + (size_t)(3 * D + 768) * D * 2;
constexpr size_t WS_WRO = WS_WLB + (size_t)5 * D * 256 * 2;
constexpr size_t WS_XN = WS_WRO + SZ_WDD;
constexpr size_t WS_H = WS_XN + (size_t)6 * M * D * 2;
constexpr size_t WS_QKV = WS_H + al256((size_t)M * DFF * 2);
constexpr size_t WS_KB = WS_QKV + (size_t)M * QKVD * 2, WS_VB = WS_KB + (size_t)M * AKV * HD * 2;
constexpr size_t WS_OB = WS_VB + (size_t)M * AKV * HD * 2;
constexpr size_t WS_MPROJ = WS_OB + (size_t)M * D * 2;
constexpr size_t WS_GATES = WS_MPROJ + (size_t)M * MIN * 2;
constexpr size_t WS_HDIR = WS_GATES + al256((size_t)M * NGATE * 4);
constexpr size_t WS_RKV = WS_HDIR + (size_t)2 * M * D * 2;
constexpr size_t WS_LAB = WS_RKV + (size_t)3 * M * D * 2;
constexpr size_t WS_DEC = WS_LAB + (size_t)3 * M * 256 * 2;
constexpr size_t WS_AG = WS_DEC + (size_t)2 * M * D * 4;
constexpr size_t WS_YDIR = WS_AG + (size_t)3 * M * D * 2;
constexpr size_t WS_SLAB = WS_YDIR + (size_t)2 * M * D * 2;
constexpr size_t WS_END = WS_SLAB + (size_t)768 * 262144;
constexpr int CW_BAR = 4096;

constexpr int RING_BYTES = 131072, LDSCTL_OFF = RING_BYTES, MISC_OFF = LDSCTL_OFF + 320, LDS_BYTES = 147456;
constexpr int NWAVES = 8, NTHR = 512;

typedef unsigned short bf16;
typedef float f32x4 __attribute__((ext_vector_type(4)));
typedef float f32x2 __attribute__((ext_vector_type(2)));
typedef short bf16x8 __attribute__((ext_vector_type(8)));
typedef short s16x4 __attribute__((ext_vector_type(4)));
typedef unsigned u32x4 __attribute__((ext_vector_type(4)));
typedef unsigned u32x2 __attribute__((ext_vector_type(2)));

#ifdef HIPEMU
DI unsigned f2bf(float f) { unsigned u = __float_as_uint(f); return (u + 0x7fffu + ((u >> 16) & 1u)) >> 16; }
DI unsigned pk2(float lo, float hi) { return f2bf(lo) | (f2bf(hi) << 16); }
DI float fast_rcp(float x) { return 1.0f / x; }
#else
DI unsigned pk2(float lo, float hi) { unsigned r; asm("v_cvt_pk_bf16_f32 %0, %1, %2" : "=v"(r) : "v"(lo), "v"(hi)); return r; }
DI unsigned f2bf(float f) { return pk2(f, 0.f) & 0xffffu; }
DI float fast_rcp(float x) { return __builtin_amdgcn_rcpf(x); }
#endif
#ifndef FFN_OUT_FP8
#define FFN_OUT_FP8 1
#endif
#ifndef FFN_IN_FP8_FROM
#define FFN_IN_FP8_FROM 3
#endif
constexpr float WFI_SCALE = 32.0f;
constexpr float WFO_SCALE = 64.0f;
#ifdef HIPEMU
DI unsigned f2e4m3(float f) { const unsigned s = f < 0.f ? 0x80u : 0u; float a = fabsf(f); if (!(a == a)) return 0x7fu; if (a > 448.f) a = 448.f; if (a < 0.0009765625f) return s;
    int e; frexpf(a, &e); e -= 1; if (e < -6) e = -6; const float step = ldexpf(1.0f, e - 3); float q = rintf(a / step);
    float v = q * step; if (v > 448.f) v = 448.f; if (v == 0.f) return s; int e2; frexpf(v, &e2); e2 -= 1; if (e2 < -6) { return s | (unsigned)(v / ldexpf(1.0f, -9)); }
    const unsigned m = (unsigned)(v / ldexpf(1.0f, e2 - 3)) - 8u; return s | ((unsigned)(e2 + 7) << 3) | m; }
DI float e4m32f(unsigned b) { const float s = (b & 0x80u) ? -1.f : 1.f; const int e = (b >> 3) & 15, m = b & 7; return e == 0 ? s * ldexpf((float)m, -9) : s * ldexpf((float)(8 + m), e - 10); }
DI unsigned pk4_fp8(float a, float b, float c, float d) { return f2e4m3(a) | (f2e4m3(b) << 8) | (f2e4m3(c) << 16) | (f2e4m3(d) << 24); }
#else
DI unsigned pk4_fp8(float a, float b, float c, float d) { int v = __builtin_amdgcn_cvt_pk_fp8_f32(a, b, 0, false); v = __builtin_amdgcn_cvt_pk_fp8_f32(c, d, v, true); return (unsigned)v; }
#endif
#ifdef HIPEMU
DI float fast_exp2(float x) { return exp2f(x); }
#else
DI float fast_exp2(float x) { return __builtin_amdgcn_exp2f(x); }
#endif
DI float bf2f(unsigned b) { return __uint_as_float(b << 16); }
DI float bflo(unsigned w) { return __uint_as_float(w << 16); }
DI float bfhi(unsigned w) { return __uint_as_float(w & 0xffff0000u); }
DI float wave_sum(float v) {
#ifdef HIPEMU
#pragma unroll
    for (int o = 1; o < 64; o <<= 1) v += __shfl_xor(v, o);
    return v;
#else
#define DPP_ADD(ctrl) v += __builtin_bit_cast(float, __builtin_amdgcn_update_dpp(0, __builtin_bit_cast(int, v), ctrl, 0xF, 0xF, true))
    DPP_ADD(0xB1); DPP_ADD(0x4E); DPP_ADD(0x141); DPP_ADD(0x140);
#undef DPP_ADD
    const int iv = __builtin_bit_cast(int, v);
    const float r0 = __builtin_bit_cast(float, __builtin_amdgcn_readlane(iv, 0)), r1 = __builtin_bit_cast(float, __builtin_amdgcn_readlane(iv, 16));
    const float r2 = __builtin_bit_cast(float, __builtin_amdgcn_readlane(iv, 32)), r3 = __builtin_bit_cast(float, __builtin_amdgcn_readlane(iv, 48));
    return (r0 + r1) + (r2 + r3);
#endif
}
DI float wave_max(float v) {
#pragma unroll
    for (int o = 1; o < 64; o <<= 1) v = fmaxf(v, __shfl_xor(v, o));
    return v;
}
DI float sigmoidf_(float x) { return fast_rcp(1.0f + __expf(-x)); }
DI float siluf_(float x) { return x * fast_rcp(1.0f + __expf(-x)); }
DI int cond_of_row(int row) { return row < MC ? 0 : 1 + (row - MC) / TL; }

DI int opq(int x) {
#ifndef HIPEMU
    asm volatile("" : "+s"(x));
#endif
    return x; }
#ifndef HIPEMU
namespace pg8 {
#define PG8_LAS __attribute__((address_space(3)))
typedef unsigned short bf16_t;
typedef short bf16x8 __attribute__((ext_vector_type(8)));
typedef float f32x4 __attribute__((ext_vector_type(4)));
typedef unsigned u32x4 __attribute__((ext_vector_type(4)));
typedef int i32x4 __attribute__((ext_vector_type(4)));
constexpr int BM = 256, BK = 64, HALF = 128, HTB = HALF * BK * 2  , STAGE_BYTES = 8 * HTB, NXCD = 8, WGM = 8;

__host__ __device__ __forceinline__ int lds_byte(int r, int c) { const int st = (r >> 4) * 2 + (c >> 5), rr = r & 15, cc = c & 31, ob = rr * 64 + cc * 2; return st * 1024 + (ob ^ (((ob >> 9) & 1) << 5)); }
__host__ __device__ __forceinline__ void stage_rc(int b, int& R, int& C) { const int st = b / 1024, sb = b % 1024, swz = sb ^ (((sb >> 9) & 1) << 5); R = (st >> 1) * 16 + swz / 64; C = (st & 1) * 32 + (swz % 64) / 2; }
__host__ __device__ __forceinline__ int perm32(int rho) { const int n = rho >> 4, i = rho & 15; return 8 * (i >> 2) + 4 * n + (i & 3); }

struct Unit { int pm, pn, k0, nt, role, slot, half; };
struct Gemm { const bf16_t* A; const bf16_t* Bt; int M, N, K; };

template <class Epi, class Sched, bool ALIGN_EPI = false, bool SP2 = false, bool FP8 = false>
__device__ __forceinline__ void gemm_phase(PG8_LAS unsigned char* lds, const Gemm g, const Sched& S, const Epi& E) {
    int tid_ = threadIdx.x; asm volatile("" : "+v"(tid_));
    const int tid = tid_, wid = __builtin_amdgcn_readfirstlane(tid >> 6), lane = tid & 63, wr = wid >> 2, wc = wid & 3, fr = lane & 15, fq = lane >> 4;
    const int K = g.K;
    unsigned voffA[2], voffB[2];
#pragma unroll
    for (int i = 0; i < 2; ++i) { int R, C; stage_rc(tid * 16 + i * 8192, R, C); const int Rb = Epi::PERM ? ((R & ~31) + perm32(R & 31)) : R;
        voffA[i] = (unsigned)(R * K + C) * 2u; voffB[i] = (unsigned)(Rb * K + C) * 2u; }
    const size_t kstep = (size_t)(BK * 2);
    const size_t hstep = (size_t)HALF * K * 2;
    const size_t tstep = 2 * hstep;
    const unsigned ldsw = (unsigned)wid * 1024u;
    const int aoff = lds_byte(wr * 64 + fr, fq * 8), boff = lds_byte(wc * 32 + fr, fq * 8);
#define PG8_SA(b, h) (((b) * 2 + (h)) * HTB)
#define PG8_SB(b, h) ((4 + (b) * 2 + (h)) * HTB)
#define PG8_STAGE(bufoff, gbase, voff) do { _Pragma("unroll") for (int _i = 0; _i < 2; ++_i) \
        __builtin_amdgcn_global_load_lds((const unsigned*)((const char*)(gbase) + (voff)[_i]), (PG8_LAS unsigned*)(lds + (bufoff) + ldsw + _i * 8192), 16, 0, 0); } while (0)
#define PG8_LDA(dst, b, h) do { _Pragma("unroll") for (int m = 0; m < 4; ++m) _Pragma("unroll") for (int k = 0; k < 2; ++k) dst[m][k] = *(const PG8_LAS bf16x8*)(lds + PG8_SA(b, h) + aoff + m * 2048 + k * 1024); } while (0)
#define PG8_LDB(dst, b, h) do { _Pragma("unroll") for (int n = 0; n < 2; ++n) _Pragma("unroll") for (int k = 0; k < 2; ++k) dst[n][k] = *(const PG8_LAS bf16x8*)(lds + PG8_SB(b, h) + boff + n * 2048 + k * 1024); } while (0)
#define PG8_CAT8(x) __builtin_shufflevector(__builtin_bit_cast(i32x4, x[0]), __builtin_bit_cast(i32x4, x[1]), 0, 1, 2, 3, 4, 5, 6, 7)
#define PG8_MMA(ai, bj, At, Bt) do { __builtin_amdgcn_s_setprio(1); _Pragma("unroll") for (int m = 0; m < 4; ++m) _Pragma("unroll") for (int n = 0; n < 2; ++n) { \
        if constexpr (FP8) acc[ai][bj][m][n] = __builtin_amdgcn_mfma_scale_f32_16x16x128_f8f6f4(PG8_CAT8(Bt[n]), PG8_CAT8(At[m]), acc[ai][bj][m][n], 0, 0, 0, 0, 0, 0); \
        else { _Pragma("unroll") for (int k = 0; k < 2; ++k) acc[ai][bj][m][n] = __builtin_amdgcn_mfma_f32_16x16x32_bf16(Bt[n][k], At[m][k], acc[ai][bj][m][n], 0, 0, 0); } } __builtin_amdgcn_s_setprio(0); } while (0)
#define PG8_WAIT_V(n) asm volatile("s_waitcnt vmcnt(" #n ")" ::: "memory")
#define PG8_WAIT_L(n) asm volatile("s_waitcnt lgkmcnt(" #n ")" ::: "memory")
#define PG8_BAR __builtin_amdgcn_s_barrier()
#define PG8_SCHED __builtin_amdgcn_sched_barrier(0)
    Unit cur, nxt; int ui = 0;
    if (!S.next(0, cur)) return;
    f32x4 acc[2][2][4][2];
    E.init_acc(acc, cur);
    bf16x8 At[4][2], B0[2][2], B1[2][2];
    const char* cA = (const char*)g.A + (size_t)cur.pm * tstep + (size_t)cur.k0 * kstep + (cur.half == 2 ? hstep : 0); const char* cB = (const char*)g.Bt + (size_t)cur.pn * tstep + (size_t)cur.k0 * kstep;
    S.a_ready(cur);
    if constexpr (SP2) {
        PG8_STAGE(PG8_SB(0, 0), cB, voffB); PG8_STAGE(PG8_SB(0, 1), cB + hstep, voffB); PG8_STAGE(PG8_SA(0, 0), cA, voffA); PG8_STAGE(PG8_SA(0, 1), cA + hstep, voffA);
        if (wr == 1) PG8_BAR;
        PG8_WAIT_V(2); PG8_BAR;
        PG8_STAGE(PG8_SB(1, 0), cB + kstep, voffB); PG8_STAGE(PG8_SA(1, 0), cA + kstep, voffA); PG8_STAGE(PG8_SB(1, 1), cB + hstep + kstep, voffB);
        PG8_WAIT_V(6); PG8_BAR;
    } else {
        PG8_STAGE(PG8_SB(0, 0), cB, voffB); PG8_STAGE(PG8_SA(0, 0), cA, voffA); PG8_STAGE(PG8_SB(0, 1), cB + hstep, voffB); PG8_STAGE(PG8_SA(0, 1), cA + hstep, voffA);
        if (wr == 1) PG8_BAR;
        PG8_WAIT_V(4); PG8_BAR;
        PG8_STAGE(PG8_SB(1, 0), cB + kstep, voffB); PG8_STAGE(PG8_SA(1, 0), cA + kstep, voffA); PG8_STAGE(PG8_SB(1, 1), cB + hstep + kstep, voffB);
        PG8_WAIT_V(6); PG8_BAR;
    }
    for (;;) {
        const bool has_next = S.next(ui + 1, nxt);
        const char* nA = has_next ? (const char*)g.A + (size_t)nxt.pm * tstep + (size_t)nxt.k0 * kstep + (nxt.half == 2 ? hstep : 0) : cA; const char* nB = has_next ? (const char*)g.Bt + (size_t)nxt.pn * tstep + (size_t)nxt.k0 * kstep : cB;
        const int nt = cur.nt; const bool full = cur.half == 0;
        for (int t = 0; t < nt; t += 2) {
            const bool last = (t == nt - 2);
            const char* a1 = cA + (size_t)(t + 1) * kstep;
            const char* a2 = last ? nA : cA + (size_t)(t + 2) * kstep; const char* b2 = last ? nB : cB + (size_t)(t + 2) * kstep;
            const char* a3 = a2 + kstep; const char* b3 = b2 + kstep;
            if (last && has_next) S.a_ready(nxt);
            if constexpr (SP2) {
            PG8_LDB(B0, 0, 0); PG8_LDB(B1, 0, 1); PG8_SCHED; PG8_LDA(At, 0, 0); PG8_STAGE(PG8_SA(1, 1), a1 + hstep, voffA);
            PG8_WAIT_V(8); PG8_WAIT_L(0); PG8_BAR; PG8_MMA(0, 0, At, B0); PG8_MMA(0, 1, At, B1); PG8_BAR; PG8_SCHED;
            PG8_LDA(At, 0, 1); PG8_STAGE(PG8_SB(0, 0), b2, voffB); PG8_STAGE(PG8_SB(0, 1), b2 + hstep, voffB); PG8_STAGE(PG8_SA(0, 0), a2, voffA);
            PG8_WAIT_V(8); PG8_WAIT_L(0); PG8_BAR; if (full) { PG8_MMA(1, 0, At, B0); PG8_MMA(1, 1, At, B1); } PG8_BAR; PG8_SCHED;
            PG8_LDB(B0, 1, 0); PG8_LDB(B1, 1, 1); PG8_SCHED; PG8_LDA(At, 1, 0); PG8_STAGE(PG8_SA(0, 1), a2 + hstep, voffA);
            PG8_WAIT_V(8); PG8_WAIT_L(0); PG8_BAR; PG8_MMA(0, 0, At, B0); PG8_MMA(0, 1, At, B1); PG8_BAR; PG8_SCHED;
            PG8_LDA(At, 1, 1); PG8_STAGE(PG8_SB(1, 0), b3, voffB); PG8_STAGE(PG8_SB(1, 1), b3 + hstep, voffB); PG8_STAGE(PG8_SA(1, 0), a3, voffA);
            PG8_WAIT_V(8); PG8_WAIT_L(0); PG8_BAR; if (full) { PG8_MMA(1, 0, At, B0); PG8_MMA(1, 1, At, B1); } PG8_BAR; PG8_SCHED;
            } else {
            PG8_LDB(B0, 0, 0); PG8_SCHED; PG8_LDA(At, 0, 0); PG8_STAGE(PG8_SA(1, 1), a1 + hstep, voffA);
            PG8_WAIT_L(8); PG8_BAR; PG8_WAIT_L(0); PG8_MMA(0, 0, At, B0); PG8_BAR; PG8_SCHED;
            PG8_LDB(B1, 0, 1); PG8_STAGE(PG8_SB(0, 0), b2, voffB);
            PG8_BAR; PG8_WAIT_L(0); PG8_MMA(0, 1, At, B1); PG8_BAR;
            PG8_LDA(At, 0, 1); PG8_STAGE(PG8_SA(0, 0), a2, voffA);
            PG8_BAR; PG8_WAIT_L(0); PG8_MMA(1, 0, At, B0); PG8_BAR; PG8_SCHED;
            PG8_STAGE(PG8_SB(0, 1), b2 + hstep, voffB);
            PG8_WAIT_V(6); PG8_BAR; PG8_MMA(1, 1, At, B1); PG8_BAR;
            PG8_LDB(B0, 1, 0); PG8_SCHED; PG8_LDA(At, 1, 0); PG8_STAGE(PG8_SA(0, 1), a2 + hstep, voffA);
            PG8_WAIT_L(8); PG8_BAR; PG8_WAIT_L(0); PG8_MMA(0, 0, At, B0); PG8_BAR; PG8_SCHED;
            PG8_LDB(B1, 1, 1); PG8_STAGE(PG8_SB(1, 0), b3, voffB);
            PG8_BAR; PG8_WAIT_L(0); PG8_MMA(0, 1, At, B1); PG8_BAR;
            PG8_LDA(At, 1, 1); PG8_STAGE(PG8_SA(1, 0), a3, voffA);
            PG8_BAR; PG8_WAIT_L(0); PG8_MMA(1, 0, At, B0); PG8_BAR; PG8_SCHED;
            PG8_STAGE(PG8_SB(1, 1), b3 + hstep, voffB);
            PG8_WAIT_V(6); PG8_BAR; PG8_MMA(1, 1, At, B1); PG8_BAR;
            }
        }
        if constexpr (ALIGN_EPI) { if (wr == 0) PG8_BAR; }
        if constexpr (!Epi::AFTER_DRAIN) { E(acc, cur, wr, wc, fr, fq); S.done(cur); }
        if (!has_next) break;
        E.init_acc(acc, nxt);
        cur = nxt; cA = nA; cB = nB; ++ui;
        if constexpr (ALIGN_EPI) { if (wr == 1) PG8_BAR; }
    }
    PG8_WAIT_V(0);
    if constexpr (!ALIGN_EPI) { if (wr == 0) PG8_BAR; }
    PG8_BAR;
    if constexpr (Epi::AFTER_DRAIN) { E.fused(acc, cur, wr, wc, fr, fq, lds, wid, lane); S.done(cur); }
#undef PG8_SA
#undef PG8_SB
#undef PG8_STAGE
#undef PG8_LDA
#undef PG8_LDB
#undef PG8_MMA
#undef PG8_CAT8
#undef PG8_WAIT_V
#undef PG8_WAIT_L
#undef PG8_BAR
#undef PG8_SCHED
}
}
#else
namespace pg8 {
#define PG8_LAS
typedef unsigned short bf16_t;
typedef short bf16x8 __attribute__((ext_vector_type(8)));
typedef float f32x4 __attribute__((ext_vector_type(4)));
typedef unsigned u32x4 __attribute__((ext_vector_type(4)));
constexpr int BM = 256, BK = 64, HALF = 128, STAGE_BYTES = 131072;
struct Unit { int pm, pn, k0, nt, role, slot, half; };
struct Gemm { const bf16_t* A; const bf16_t* Bt; int M, N, K; };
extern float* emu_tile;
template <class Epi, class Sched, bool ALIGN_EPI = false, bool SP2 = false, bool FP8 = false>
inline void gemm_phase(unsigned char* lds, const Gemm g, const Sched& S, const Epi& E) {
    const int tid = threadIdx.x, wid = tid >> 6, lane = tid & 63, wr = wid >> 2, wc = wid & 3, fr = lane & 15, fq = lane >> 4;
    Unit u; float* tile = emu_tile + (size_t)blockIdx.x * 65536;
    for (int i = 0; S.next(i, u); ++i) {
        __syncthreads();
        if (tid == 0) {
            for (int r = 0; r < 256; ++r) for (int c = 0; c < 256; ++c) {
                if (u.half && r >= 128) { tile[r * 256 + c] = 0.f; continue; }
                const bf16_t* a = g.A + ((size_t)u.pm * 256 + r + (u.half == 2 ? 128 : 0)) * g.K; const bf16_t* b = g.Bt + ((size_t)u.pn * 256 + c) * g.K; float s = 0.f;
                if (FP8) { const unsigned char* a8 = (const unsigned char*)a; const unsigned char* b8 = (const unsigned char*)b; for (int k = u.k0 * 128; k < (u.k0 + u.nt) * 128; ++k) s += e4m32f(a8[k]) * e4m32f(b8[k]); }
                else
                for (int k = u.k0 * 64; k < (u.k0 + u.nt) * 64; ++k) { unsigned ua = (unsigned)a[k] << 16, ub = (unsigned)b[k] << 16; float fa, fb; memcpy(&fa, &ua, 4); memcpy(&fb, &ub, 4); s += fa * fb; }
                tile[r * 256 + c] = s; }
        }
        __syncthreads();
        f32x4 acc[2][2][4][2];
        E.init_acc(acc, u);
        for (int ai = 0; ai < 2; ++ai) for (int bj = 0; bj < 2; ++bj) for (int m = 0; m < 4; ++m) for (int n = 0; n < 2; ++n) for (int j = 0; j < 4; ++j) {
            const int r = 128 * ai + 64 * wr + 16 * m + fr, c = Epi::PERM ? 128 * bj + 32 * wc + 8 * fq + 4 * n + j : 128 * bj + 32 * wc + 16 * n + 4 * fq + j;
            acc[ai][bj][m][n][j] += tile[r * 256 + c]; }
        E(acc, u, wr, wc, fr, fq);
    }
    __syncthreads();
}
}
#endif

DI void map_unit(int L, int nM, int nN, int& pm, int& pn) {
    const int nwg = nM * nN; int wgid = L;
    { const int q = nwg / 8, r = nwg % 8, xcd = wgid % 8, off = wgid / 8; wgid = (xcd < r ? xcd * (q + 1) : r * (q + 1) + (xcd - r) * q) + off; }
    const int nig = 8 * nN, gid = wgid / nig, fm = gid * 8, gsz = (nM - fm) < 8 ? (nM - fm) : 8;
    pm = fm + ((wgid % nig) % gsz); pn = (wgid % nig) / gsz;
}
struct MapSimple { int nM, nN, same; DI int total() const { return nM * nN; } DI void operator()(int L, int& pm, int& pn) const { map_unit(L, nM, nN, pm, pn); if (same) { pm = 0; pn = 0; } } };
struct MapRwkv1 {
    DI int total() const { return 3 * NM * (D / 256) + 3 * NM; }
    DI void operator()(int L, int& pm, int& pn) const { const int nN = D / 256, big = NM * nN;
        if (L < 3 * big) { const int p = L / big; int a, b; map_unit(L % big, NM, nN, a, b); pm = p * NM + a; pn = p * nN + b; }
        else { L -= 3 * big; const int p = L / NM; pm = (3 + p) * NM + L % NM; pn = 3 * nN + p; } }
};
struct MapRwkv2 {
    DI int total() const { return 5 * NM * (D / 256); }
    DI void operator()(int L, int& pm, int& pn) const { const int nN = D / 256, big = NM * nN; const int j = L / big; int a, b; map_unit(L % big, NM, nN, a, b);
        const int aidx = j < 2 ? 0 : (j < 4 ? 1 : 2); pm = aidx * NM + a; pn = j * nN + b; }
};
#ifndef KSPLIT_SKEW
#define KSPLIT_SKEW 2
#endif
template <class Map> struct OrderSplit {
    Map map; int ntK, G_, c_, allow4;
#ifndef HALF_TAIL
#define HALF_TAIL 1
#endif
#ifndef SPLIT_MODE
#define SPLIT_MODE 0
#endif
    DI int choose_P(int rem, int G) const { if (rem == 0 || SPLIT_MODE == 0) return 1; if (!(SPLIT_MODE == 2 || allow4) && 2 * rem != G) return 1;
        if (ntK >= 16 && ntK % 8 == 0 && 2 * rem != G) return 4; if (ntK >= 8 && ntK % 4 == 0) return 2; return 1; }
    DI bool next(int i, pg8::Unit& u) const {
        const int G = opq(G_), c = opq(c_);
        const int U = map.total(), R = U / G, rem = U - R * G, P = choose_P(rem, G);
        u.k0 = 0; u.nt = ntK; u.role = 0; u.slot = 0; u.half = 0;
        if (P == 1) {
            if (HALF_TAIL && rem > 0 && 2 * rem <= G) {
                if (i < R) { map(i * G + c, u.pm, u.pn); return true; }
                if (i > R || c >= 2 * rem) return false;
                map(R * G + c % rem, u.pm, u.pn); u.half = 1 + c / rem; return true; }
            const long L = (long)i * G + c; if (L >= U) return false; map((int)L, u.pm, u.pn); return true; }
        const int nprod = rem * (P - 1), ntp = ntK / P + (P == 2 && ntK >= 16 ? KSPLIT_SKEW : 0);
        const int np = c < nprod ? (nprod - 1 - c) / G + 1 : 0;
        if (i < np) { const int idx = c + i * G, su = idx / (P - 1), j = idx % (P - 1); map(R * G + su, u.pm, u.pn); u.k0 = j * ntp; u.nt = ntp; u.role = 1; u.slot = idx; return true; }
        i -= np;
        if (i < R) { map(i * G + c, u.pm, u.pn); return true; }
        i -= R;
        const int su = G - 1 - c + i * G; if (i > 0 || su >= rem) return false;
        map(R * G + su, u.pm, u.pn); u.k0 = (P - 1) * ntp; u.nt = ntK - u.k0; u.role = 2; u.slot = su; return true;
    }
    DI int nprod_per_unit() const { const int U = map.total(), rem = U % G_; return choose_P(rem, G_) - 1; }
    DI void a_ready(const pg8::Unit&) const {}
    DI void done(const pg8::Unit&) const {}
};

typedef const pg8::f32x4 (&AccRef)[2][2][4][2];
template <bool S8> struct EpiSwigluT {
    static constexpr bool PERM = true, AFTER_DRAIN = false;
    bf16* H; int skip;
    DI void operator()(AccRef acc, const pg8::Unit& u, int wr, int wc, int fr, int fq) const {
        if (skip) return;
        const int row0 = u.pm * 256 + wr * 64 + fr + (u.half == 2 ? 128 : 0), col0 = u.pn * 128 + wc * 32 + 8 * fq;
#pragma unroll
        for (int ai = 0; ai < 2; ++ai) { if (ai == 1 && u.half) break;
#pragma unroll
            for (int m = 0; m < 4; ++m) {
                float h[8];
#pragma unroll
                for (int n = 0; n < 2; ++n)
#pragma unroll
                    for (int j = 0; j < 4; ++j) { const float gt = acc[ai][0][m][n][j], up = acc[ai][1][m][n][j];
                        if constexpr (S8) { constexpr float S2 = WFI_SCALE * WFI_SCALE;
                            h[4 * n + j] = (gt * up) * fast_rcp(fmaf(fast_exp2(gt * (-1.44269504f / WFI_SCALE)), S2, S2)); }
                        else h[4 * n + j] = siluf_(gt) * up; }
#if FFN_OUT_FP8
                u32x2 w; w.x = pk4_fp8(h[0], h[1], h[2], h[3]); w.y = pk4_fp8(h[4], h[5], h[6], h[7]);
                *(u32x2*)((unsigned char*)H + (size_t)(row0 + ai * 128 + m * 16) * DFF + col0) = w;
#else
                u32x4 w; w.x = pk2(h[0], h[1]); w.y = pk2(h[2], h[3]); w.z = pk2(h[4], h[5]); w.w = pk2(h[6], h[7]);
                *(u32x4*)(H + (size_t)(row0 + ai * 128 + m * 16) * DFF + col0) = w;
#endif
            } }
    }
};
typedef EpiSwigluT<false> EpiSwiglu; typedef EpiSwigluT<true> EpiSwiglu8;
struct EpiResid {
    static constexpr bool PERM = false, AFTER_DRAIN = false;
    float* X; const float* gate0;
    float gs; int skip;
    const float* xin_c; const float* xin_l;
    DI void operator()(AccRef acc, const pg8::Unit& u, int wr, int wc, int fr, int fq) const {
        if (skip) return;
        const int row0 = u.pm * 256 + wr * 64 + fr + (u.half == 2 ? 128 : 0), col0 = u.pn * 256 + wc * 32 + 4 * fq;
        const float* Xr = xin_c ? (u.pm * 256 < MC ? xin_c : xin_l - (size_t)MC * D) : X;
        const float* gp = gate0 + (size_t)cond_of_row(u.pm * 256) * NMOD * D + col0;
        f32x4 gv[2][2];
#pragma unroll
        for (int bj = 0; bj < 2; ++bj)
#pragma unroll
            for (int n = 0; n < 2; ++n) gv[bj][n] = *(const f32x4*)(gp + bj * 128 + n * 16) * gs;
#pragma unroll
        for (int ai = 0; ai < 2; ++ai) { if (ai == 1 && u.half) break;
#pragma unroll
            for (int mp = 0; mp < 2; ++mp) { const size_t o0 = (size_t)(row0 + ai * 128 + mp * 32) * D + col0;
                f32x4 xv[2][2][2];
#pragma unroll
                for (int m = 0; m < 2; ++m)
#pragma unroll
                    for (int bj = 0; bj < 2; ++bj)
#pragma unroll
                        for (int n = 0; n < 2; ++n) xv[m][bj][n] = *(const f32x4*)(Xr + o0 + (size_t)m * 16 * D + bj * 128 + n * 16);
#pragma unroll
                for (int m = 0; m < 2; ++m)
#pragma unroll
                    for (int bj = 0; bj < 2; ++bj)
#pragma unroll
                        for (int n = 0; n < 2; ++n) *(f32x4*)(X + o0 + (size_t)m * 16 * D + bj * 128 + n * 16) = xv[m][bj][n] + gv[bj][n] * acc[ai][bj][2 * mp + m][n]; } }
    }
};
struct EpiBf16 {
    static constexpr bool PERM = true, AFTER_DRAIN = false;
    bf16* O; int ldc;
    DI void operator()(AccRef acc, const pg8::Unit& u, int wr, int wc, int fr, int fq) const {
        const int row0 = u.pm * 256 + wr * 64 + fr + (u.half == 2 ? 128 : 0), col0 = u.pn * 256 + wc * 32 + 8 * fq;
#pragma unroll
        for (int ai = 0; ai < 2; ++ai) { if (ai == 1 && u.half) break;
#pragma unroll
            for (int m = 0; m < 4; ++m) { bf16* rowp = O + (size_t)(row0 + ai * 128 + m * 16) * ldc + col0;
#pragma unroll
                for (int bj = 0; bj < 2; ++bj) { const pg8::f32x4 v0 = acc[ai][bj][m][0], v1 = acc[ai][bj][m][1];
                    u32x4 w; w.x = pk2(v0[0], v0[1]); w.y = pk2(v0[2], v0[3]); w.z = pk2(v1[0], v1[1]); w.w = pk2(v1[2], v1[3]);
                    *(u32x4*)(rowp + bj * 128) = w; } } }
    }
};
struct EpiMlstmIn {
    static constexpr bool PERM = true, AFTER_DRAIN = false;
    bf16* P; float* Gt; const float* bg;
    DI void operator()(AccRef acc, const pg8::Unit& u, int wr, int wc, int fr, int fq) const {
        const int row0 = u.pm * 256 + wr * 64 + fr + (u.half == 2 ? 128 : 0);
        if (u.pn < MIN / 256) { EpiBf16 e{P, MIN}; e(acc, u, wr, wc, fr, fq); return; }
        if (wc != 0) return;
        f32x4 bv[2];
#pragma unroll
        for (int n = 0; n < 2; ++n) bv[n] = 8 * fq + 4 * n < NGATE ? *(const f32x4*)(bg + 8 * fq + 4 * n) : (f32x4){0.f, 0.f, 0.f, 0.f};
#pragma unroll
        for (int ai = 0; ai < 2; ++ai) { if (ai == 1 && u.half) break;
#pragma unroll
            for (int m = 0; m < 4; ++m)
#pragma unroll
                for (int n = 0; n < 2; ++n) if (8 * fq + 4 * n < NGATE) *(f32x4*)(Gt + (size_t)(row0 + ai * 128 + m * 16) * NGATE + 8 * fq + 4 * n) = acc[ai][0][m][n] + bv[n]; }
    }
};
struct EpiRwkv1 {
    static constexpr bool PERM = true, AFTER_DRAIN = false;
    bf16* RKV; bf16* LAB;
    DI void operator()(AccRef acc, const pg8::Unit& u, int wr, int wc, int fr, int fq) const {
        const int p = u.pm / NM, pm = u.pm % NM; const int row0 = pm * 256 + wr * 64 + fr + (u.half == 2 ? 128 : 0);
        const int q = p - 3; const int col0 = (p < 3 ? (u.pn - p * (D / 256)) * 256 : 0) + wc * 32 + 8 * fq, ld = p < 3 ? D : 256;
        bf16* base = p < 3 ? RKV + (size_t)p * M * D : LAB + (size_t)q * M * 256;
#pragma unroll
        for (int ai = 0; ai < 2; ++ai) { if (ai == 1 && u.half) break;
#pragma unroll
            for (int m = 0; m < 4; ++m) { bf16* rowp = base + (size_t)(row0 + ai * 128 + m * 16) * ld + col0;
#pragma unroll
                for (int bj = 0; bj < 2; ++bj) { float h[8];
#pragma unroll
                    for (int n = 0; n < 2; ++n)
#pragma unroll
                        for (int j = 0; j < 4; ++j) { const float x = acc[ai][bj][m][n][j]; h[4 * n + j] = q == 0 ? tanhf(x) : (q == 2 ? sigmoidf_(x) : x); }
                    u32x4 w; w.x = pk2(h[0], h[1]); w.y = pk2(h[2], h[3]); w.z = pk2(h[4], h[5]); w.w = pk2(h[6], h[7]);
                    *(u32x4*)(rowp + bj * 128) = w; } } }
    }
};
struct EpiRwkv2 {
    static constexpr bool PERM = false, AFTER_DRAIN = false;
    float* DEC; bf16* AG; const float* w0; const float* a0;
    DI void operator()(AccRef acc, const pg8::Unit& u, int wr, int wc, int fr, int fq) const {
        const int j = u.pn / (D / 256), pn = u.pn % (D / 256), pm = u.pm % NM;
        const int row0 = pm * 256 + wr * 64 + fr + (u.half == 2 ? 128 : 0), col0 = pn * 256 + wc * 32 + 4 * fq;
        const float* bsrc = j < 2 ? w0 + j * D : a0 + (j < 4 ? j - 2 : 0) * D;
        const int mode = j < 2 ? 0 : (j < 4 ? 1 : 2);
        f32x4 bnext = mode < 2 ? *(const f32x4*)(bsrc + col0) : (f32x4){0.f, 0.f, 0.f, 0.f};
#pragma unroll
        for (int bn = 0; bn < 4; ++bn) { const int bj = bn >> 1, n = bn & 1; const int c = col0 + bj * 128 + n * 16;
            const f32x4 bv = bnext; if (bn < 3 && mode < 2) bnext = *(const f32x4*)(bsrc + col0 + ((bn + 1) >> 1) * 128 + ((bn + 1) & 1) * 16);
#pragma unroll
            for (int ai = 0; ai < 2; ++ai) { if (ai == 1 && u.half) break;
#pragma unroll
                for (int m = 0; m < 4; ++m) { f32x4 v = acc[ai][bj][m][n] + bv; const size_t o = (size_t)(row0 + ai * 128 + m * 16) * D + c;
                    if (mode == 0) {
#pragma unroll
                        for (int e2 = 0; e2 < 4; ++e2) v[e2] = __expf(-0.60653066f * sigmoidf_(v[e2]));
                        *(f32x4*)(DEC + (size_t)j * M * D + o) = v; }
                    else { if (mode == 1) {
#pragma unroll
                            for (int e2 = 0; e2 < 4; ++e2) v[e2] = sigmoidf_(v[e2]); }
                        u32x2 w; w.x = pk2(v[0], v[1]); w.y = pk2(v[2], v[3]); *(u32x2*)(AG + (size_t)(j - 2) * M * D + o) = w; } } } }
    }
};

constexpr int SLAB_PARTS = 768;
template <class Epi> struct EpiSplit {
    static constexpr bool PERM = Epi::PERM, AFTER_DRAIN = false;
    Epi e; float* slab; unsigned* cnt; int nprod; int pskip;
    DI void init_acc(pg8::f32x4 (&acc)[2][2][4][2], const pg8::Unit& u) const {
#pragma unroll
        for (int i = 0; i < 32; ++i) acc[i >> 4][(i >> 3) & 1][(i >> 1) & 3][i & 1] = (pg8::f32x4){0.f, 0.f, 0.f, 0.f};
        if (u.role != 2 || (pskip & 1)) return;
        const int tid = threadIdx.x, su = __builtin_amdgcn_readfirstlane(u.slot); const unsigned want = 8u * (unsigned)nprod;
#ifdef HIPEMU
        while (cnt[su * 8] < want) emu::yield();
#else
        { unsigned sp = 0; while ((unsigned)__builtin_amdgcn_readfirstlane(__hip_atomic_load(cnt + su * 8, __ATOMIC_RELAXED, __HIP_MEMORY_SCOPE_AGENT)) < want) { __builtin_amdgcn_s_sleep(2); if (++sp > (1u << 24)) break; }
          __builtin_amdgcn_fence(__ATOMIC_ACQUIRE, "agent"); VM_WAIT(); }
        const __amdgpu_buffer_rsrc_t rs = __builtin_amdgcn_make_buffer_rsrc((void*)slab, 0, (int)((size_t)SLAB_PARTS * 262144), 0x00020000);
#endif
        for (int j = 0; j < nprod; ++j) { const int part = su * nprod + j;
#pragma unroll
            for (int i = 0; i < 32; ++i) {
#ifdef HIPEMU
                acc[i >> 4][(i >> 3) & 1][(i >> 1) & 3][i & 1] += ((const f32x4*)slab)[(size_t)part * 16384 + i * 512 + tid];
#else
                acc[i >> 4][(i >> 3) & 1][(i >> 1) & 3][i & 1] += __builtin_bit_cast(pg8::f32x4, __builtin_amdgcn_raw_buffer_load_b128(rs, tid * 16, part * 262144 + i * 8192, 16));
#endif
            } }
    }
    DI void operator()(pg8::f32x4 (&acc)[2][2][4][2], const pg8::Unit& u, int wr, int wc, int fr, int fq) const {
        if (u.role != 1) { e(acc, u, wr, wc, fr, fq); return; }
        if (pskip & 2) return;
        const int tid = threadIdx.x, part = __builtin_amdgcn_readfirstlane(u.slot);
#ifndef HIPEMU
        const __amdgpu_buffer_rsrc_t rs = __builtin_amdgcn_make_buffer_rsrc((void*)slab, 0, (int)((size_t)SLAB_PARTS * 262144), 0x00020000);
#endif
#pragma unroll
        for (int i = 0; i < 32; ++i) { const pg8::f32x4 v = acc[i >> 4][(i >> 3) & 1][(i >> 1) & 3][i & 1];
#ifdef HIPEMU
            ((f32x4*)slab)[(size_t)part * 16384 + i * 512 + tid] = v;
#else
            __builtin_amdgcn_raw_buffer_store_b128(__builtin_bit_cast(u32x4, v), rs, tid * 16, part * 262144 + i * 8192, 16);
#endif
        }
        VM_WAIT();
        if ((tid & 63) == 0) {
#ifdef HIPEMU
            cnt[(part / nprod) * 8] += 1u;
#else
            __hip_atomic_fetch_add(cnt + (part / nprod) * 8, 1u, __ATOMIC_RELAXED, __HIP_MEMORY_SCOPE_AGENT);
#endif
        }
    }
};

#ifndef HIPEMU
#define XB_TMO      128
#define XB_XCNT(j)  (256  + 64 * (j))
#define XB_XSUB(j)  (1280 + 64 * (j))
#define XB_XGEN(j)  (2304 + 64 * (j))
#define XB_TOP      3328
#define XB_TOPGEN   3392
#define XCD_BAR_WORDS 3456
#define XB_SPIN_CAP (1u << 22)

__device__ __forceinline__ unsigned xb_ld(unsigned* p)              { return __hip_atomic_load(p, __ATOMIC_RELAXED, __HIP_MEMORY_SCOPE_AGENT); }
__device__ __forceinline__ unsigned xb_add(unsigned* p, unsigned v) { return __hip_atomic_fetch_add(p, v, __ATOMIC_RELAXED, __HIP_MEMORY_SCOPE_AGENT); }
__device__ __forceinline__ unsigned xb_xcc_id() { return (unsigned)__builtin_amdgcn_s_getreg((3 << 11) | 20) & 0xFu; }
#define XB_SPIN(cond, bar) do { unsigned _sp = 0; while (cond) { __builtin_amdgcn_s_sleep(1); \
    if ((++_sp & 255u) == 0u) { if (xb_ld(&(bar)[XB_TMO])) break; if (_sp > XB_SPIN_CAP) { atomicAdd(&(bar)[XB_TMO], 1u); break; } } } } while (0)

struct XcdBarrier {
    unsigned* bar; unsigned x;
    volatile LAS unsigned* st;
};
__device__ __forceinline__ XcdBarrier xcd_barrier_post(unsigned* bar, volatile LAS unsigned* st) {
    XcdBarrier b; b.bar = bar; b.x = xb_xcc_id(); b.st = st;
    if (threadIdx.x == 0) (void)xb_add(&bar[XB_XCNT(b.x)], 1u);
    return b;
}
__device__ __forceinline__ void xcd_barrier_complete(unsigned* bar, unsigned x, unsigned& nloc, unsigned& nx) {
    const unsigned G = gridDim.x * gridDim.y * gridDim.z;
    unsigned sum, cnt, mine, sp = 0u;
    for (;;) {
        sum = 0u; cnt = 0u; mine = 0u;
#pragma unroll
        for (unsigned j = 0; j < 16; ++j) { const unsigned c = xb_ld(&bar[XB_XCNT(j)]); sum += c; cnt += (c > 0u) ? 1u : 0u; mine = (j == x) ? c : mine; }
        if (sum == G) break;
        __builtin_amdgcn_s_sleep(1);
        if ((++sp & 255u) == 0u) { if (xb_ld(&bar[XB_TMO])) break; if (sp > XB_SPIN_CAP) { atomicAdd(&bar[XB_TMO], 1u); break; } }
    }
    nloc = mine > 0u ? mine : 1u; nx = cnt > 0u ? cnt : 1u;
}
__device__ __forceinline__ void xcd_barrier(const XcdBarrier& b) {
    asm volatile("s_waitcnt vmcnt(0)" ::: "memory");
    __syncthreads();
    if (threadIdx.x == 0) {
        unsigned* bar = b.bar;
        __builtin_amdgcn_s_waitcnt(0);
        unsigned nloc = b.st[0], nx = b.st[1];
        if (nloc == 0u) { xcd_barrier_complete(bar, b.x, nloc, nx); b.st[0] = nloc; b.st[1] = nx; }
        const unsigned old = xb_add(&bar[XB_XSUB(b.x)], 1u);
        const unsigned gen = old / nloc;
        if (old + 1u == (gen + 1u) * nloc) {
            __builtin_amdgcn_fence(__ATOMIC_RELEASE, "agent");
            asm volatile("s_waitcnt vmcnt(0)" ::: "memory");
            const unsigned og = xb_add(&bar[XB_TOP], 1u);
            const unsigned tg = og / nx;
            if (og + 1u == (tg + 1u) * nx) xb_add(&bar[XB_TOPGEN], 1u);
            else XB_SPIN(xb_ld(&bar[XB_TOPGEN]) == tg, bar);
            __builtin_amdgcn_fence(__ATOMIC_ACQUIRE, "agent");
            xb_add(&bar[XB_XGEN(b.x)], 1u);
            asm volatile("s_waitcnt vmcnt(0)" ::: "memory");
        } else {
            XB_SPIN(xb_ld(&bar[XB_XGEN(b.x)]) == gen, bar);
            __builtin_amdgcn_fence(__ATOMIC_ACQUIRE, "agent");
            asm volatile("s_waitcnt vmcnt(0)" ::: "memory");
        }
    }
    __syncthreads();
}
#else
#define XCD_BAR_WORDS 3456
struct XcdBarrier { int dummy; };
inline void xcd_barrier(const XcdBarrier&) { emu_grid_barrier(); }
#endif

struct Args { const float* in[N_IN]; float* out; unsigned char* ws; int ph_lo, ph_hi; };
#ifdef HIPEMU
typedef const Args* ArgsP;
#else
typedef const __attribute__((address_space(4))) Args* ArgsP;
#endif
struct Frame {
    LAS unsigned char* lds;
    int tid, lane, wave, G, bx;
    ArgsP ap; float* out; unsigned char* ws;
    DI const float* inp(int i) const { return ap->in[i]; }
    DI void refresh() {
#ifndef HIPEMU
        asm volatile("" : "+s"(ap) :: "memory"); asm volatile("" : "+v"(tid));
        lane = tid & 63; wave = __builtin_amdgcn_readfirstlane(tid >> 6);
#endif
        out = ap->out; ws = ap->ws; }
};
#define WSP(T, off) ((T*)(F.ws + (off)))

DI void transpose_tile(const float* W, int ldsrc, int k0, int n0, bf16* dst_row0, int lddst, LAS float* scr, int lane) {
#pragma unroll 8
    for (int i = 0; i < 32; ++i) { const int kk = 2 * i + (lane >> 5); scr[kk * 33 + (lane & 31)] = NT_LD(W + (size_t)(k0 + kk) * ldsrc + n0 + (lane & 31)); }
    WSYNC();
    const int c = lane & 7;
#pragma unroll
    for (int j = 0; j < 4; ++j) { const int n = (lane >> 3) + 8 * j; const LAS float* s = scr + (8 * c) * 33 + n;
        u32x4 o; o.x = pk2(s[0 * 33], s[1 * 33]); o.y = pk2(s[2 * 33], s[3 * 33]); o.z = pk2(s[4 * 33], s[5 * 33]); o.w = pk2(s[6 * 33], s[7 * 33]);
        *(u32x4*)(dst_row0 + (size_t)n * lddst + k0 + 8 * c) = o; }
    WSYNC();
}
DI void transpose_tile_fp8(const float* W, int ldsrc, int k0, int n0, unsigned char* dst_row0, int lddst, float scale, LAS float* scr, int lane) {
#pragma unroll 8
    for (int i = 0; i < 32; ++i) { const int kk = 2 * i + (lane >> 5); scr[kk * 33 + (lane & 31)] = NT_LD(W + (size_t)(k0 + kk) * ldsrc + n0 + (lane & 31)) * scale; }
    WSYNC();
    const int c = lane & 7;
#pragma unroll
    for (int j = 0; j < 4; ++j) { const int n = (lane >> 3) + 8 * j; const LAS float* s = scr + (8 * c) * 33 + n;
        u32x2 o; o.x = pk4_fp8(s[0 * 33], s[1 * 33], s[2 * 33], s[3 * 33]); o.y = pk4_fp8(s[4 * 33], s[5 * 33], s[6 * 33], s[7 * 33]);
        *(u32x2*)(dst_row0 + (size_t)n * lddst + k0 + 8 * c) = o; }
    WSYNC();
}
DI void tr_plain(const float* W, int K, int N, bf16* Wt, int item, LAS float* scr, int lane) {
    const int nblk = N / 32, kb = item / nblk, nb = item % nblk;
    transpose_tile(W, N, 64 * kb, 32 * nb, Wt + (size_t)(32 * nb) * K, K, scr, lane);
}
DI void p0_prologue(Frame& F) {
    const int gw = F.bx * NWAVES + F.wave, NGW = F.G * NWAVES;
    const size_t gt = (size_t)F.bx * NTHR + F.tid, NGT = (size_t)F.G * NTHR;
    { float* rp = WSP(float, WS_ROPE);
      for (size_t i = gt; i < 64 * 32; i += NGT) { const int pos = (int)(i / 32), fi = (int)(i % 32);
          const float inv = powf(10000.0f, -(float)fi / 32.0f); const float ang = (float)pos * inv; rp[2 * i] = cosf(ang); rp[2 * i + 1] = sinf(ang); } }
    { LAS float* scr = (LAS float*)(F.lds + F.wave * 16384);
      constexpr int T_FI = (D / 64) * (2 * DFF / 32), T_FO = (DFF / 64) * (D / 32), T_QKV = (D / 64) * (QKVD / 32), T_DD = (D / 64) * (D / 32), T_MI = (D / 64) * (MIN / 32);
      constexpr int NT = 8 * T_FI + 8 * T_FO + 2 * T_QKV + 2 * T_DD + T_MI + T_DD + 3 * T_DD + T_DD;
      for (int it = gw; it < NT; it += NGW) {
          int r = it;
          if (r < 8 * T_FI) { const int hl = r / T_FI; r %= T_FI; const float* W = F.inp(I_FWI) + (size_t)hl * D * 2 * DFF; bf16* Wt = WSP(bf16, WS_WFI + hl * SZ_WFI);
              const int nblk = 2 * DFF / 32, kb = r / nblk, nb = r % nblk, n0 = 32 * nb;
              const int nn = n0 < DFF ? n0 : n0 - DFF; const int drow = 256 * (nn / 128) + (n0 < DFF ? 0 : 128) + nn % 128;
              if (hl >= FFN_IN_FP8_FROM) transpose_tile_fp8(W, 2 * DFF, 64 * kb, n0, (unsigned char*)Wt + (size_t)drow * D, D, WFI_SCALE, scr, F.lane);
              else transpose_tile(W, 2 * DFF, 64 * kb, n0, Wt + (size_t)drow * D, D, scr, F.lane);
              continue; }
          r -= 8 * T_FI;
#if FFN_OUT_FP8
          if (r < 8 * T_FO) { const int hl = r / T_FO; r %= T_FO; const int nblk = D / 32, kb = r / nblk, nb = r % nblk;
              transpose_tile_fp8(F.inp(I_FWO) + (size_t)hl * DFF * D, D, 64 * kb, 32 * nb, WSP(unsigned char, WS_WFO + hl * SZ_WFO) + (size_t)(32 * nb) * DFF, DFF, WFO_SCALE, scr, F.lane); continue; }
#else
          if (r < 8 * T_FO) { const int hl = r / T_FO; r %= T_FO; tr_plain(F.inp(I_FWO) + (size_t)hl * DFF * D, DFF, D, WSP(bf16, WS_WFO + hl * SZ_WFO), r, scr, F.lane); continue; }
#endif
          r -= 8 * T_FO;
          if (r < 2 * T_QKV) { const int s = r / T_QKV; r %= T_QKV; tr_plain(F.inp(I_AQKV) + (size_t)s * D * QKVD, D, QKVD, WSP(bf16, WS_WQKV + s * SZ_WQKV), r, scr, F.lane); continue; }
          r -= 2 * T_QKV;
          if (r < 2 * T_DD) { const int s = r / T_DD; r %= T_DD; tr_plain(F.inp(I_AWO) + (size_t)s * D * D, D, D, WSP(bf16, WS_WAO + s * SZ_WDD), r, scr, F.lane); continue; }
          r -= 2 * T_DD;
          if (r < T_MI) { tr_plain(F.inp(I_MWI), D, MIN, WSP(bf16, WS_WMI), r, scr, F.lane); continue; }
          r -= T_MI;
          if (r < T_DD) { tr_plain(F.inp(I_MWO), D, D, WSP(bf16, WS_WMO), r, scr, F.lane); continue; }
          r -= T_DD;
          if (r < 3 * T_DD) { const int p = r / T_DD; r %= T_DD; tr_plain(F.inp(I_RWRKV) + (size_t)p * D * D, D, D, WSP(bf16, WS_WRK) + (size_t)p * D * D, r, scr, F.lane); continue; }
          r -= 3 * T_DD;
          tr_plain(F.inp(I_RWO), D, D, WSP(bf16, WS_WRO), r, scr, F.lane);
      } }
    {
      bf16* g = WSP(bf16, WS_WMI) + (size_t)MIN * D; const float* wg = F.inp(I_MWG);
      for (size_t i = gt; i < (size_t)256 * D / 2; i += NGT) { const int n = (int)(i / (D / 2)), k = 2 * (int)(i % (D / 2));
          const float a = n < NGATE ? wg[(size_t)k * NGATE + n] : 0.f, b = n < NGATE ? wg[(size_t)(k + 1) * NGATE + n] : 0.f; *(unsigned*)(g + (size_t)n * D + k) = pk2(a, b); }
      bf16* la = WSP(bf16, WS_WRK) + (size_t)3 * D * D; const float* wA = F.inp(I_RWA); const float* aA = F.inp(I_RAA); const float* gA = F.inp(I_RGA);
      for (size_t i = gt; i < (size_t)768 * D / 2; i += NGT) { const int n = (int)(i / (D / 2)), k = 2 * (int)(i % (D / 2)); const int t = n / 256, c = n % 256; float a = 0.f, b = 0.f;
          if (t == 2) { a = gA[(size_t)k * LG + c]; b = gA[(size_t)(k + 1) * LG + c]; }
          else if (c < 2 * LW) { const float* src = (t == 0 ? wA : aA) + (size_t)(c / LW) * D * LW; const int cc = c % LW; a = src[(size_t)k * LW + cc]; b = src[(size_t)(k + 1) * LW + cc]; }
          *(unsigned*)(la + (size_t)n * D + k) = pk2(a, b); }
      bf16* lb = WSP(bf16, WS_WLB); const float* wB = F.inp(I_RWB); const float* aB = F.inp(I_RAB); const float* gB = F.inp(I_RGB);
      for (size_t i = gt; i < (size_t)5 * D * 128; i += NGT) { const int j = (int)(i / ((size_t)D * 128)); const int rem = (int)(i % ((size_t)D * 128)); const int n = rem / 128, k = 2 * (rem % 128); float a = 0.f, b = 0.f;
          if (j == 4) { a = gB[(size_t)k * D + n]; b = gB[(size_t)(k + 1) * D + n]; }
          else { const int z = j & 1; const float* src = (j < 2 ? wB : aB) + (size_t)z * LW * D; const int kk = k - LW * z; if (kk >= 0 && kk < LW) { a = src[(size_t)kk * D + n]; b = src[(size_t)(kk + 1) * D + n]; } }
          *(unsigned*)(lb + ((size_t)j * D + n) * 256 + k) = pk2(a, b); }
    }
    { __syncthreads();
      LAS float* sc = (LAS float*)F.lds;
      LAS float* red = (LAS float*)(F.lds + NCOND * D * 4);
      for (int i = F.tid; i < NCOND * D; i += NTHR) { const int c = i / D, k = i % D; const float v = c == 0 ? F.inp(I_CCTX)[k] : F.inp(I_C)[(size_t)(c - 1) * D + k]; sc[i] = siluf_(v); }
      __syncthreads();
      constexpr int NCG = NMOD * D / 64, NITEM = DEPTH * NCG;
      for (int it = F.bx; it < NITEM; it += F.G) {
          const int layer = it / NCG, cg = it % NCG;
          const float* W = F.inp(I_MODW) + (size_t)layer * D * NMOD * D + cg * 64 + F.lane;
          float acc[NCOND];
#pragma unroll
          for (int c = 0; c < NCOND; ++c) acc[c] = 0.f;
          const int k0 = F.wave * (D / 8);
#pragma unroll 8
          for (int k = k0; k < k0 + D / 8; ++k) { const float w = NT_LD(W + (size_t)k * NMOD * D);
#pragma unroll
              for (int c = 0; c < NCOND; ++c) acc[c] += w * sc[c * D + k]; }
#pragma unroll
          for (int c = 0; c < NCOND; ++c) red[(F.wave * NCOND + c) * 64 + F.lane] = acc[c];
          __syncthreads();
          for (int i = F.tid; i < NCOND * 64; i += NTHR) { const int c = i / 64, n = i % 64; float s2 = F.inp(I_MODB)[(size_t)layer * NMOD * D + cg * 64 + n];
#pragma unroll
              for (int w = 0; w < 8; ++w) s2 += red[(w * NCOND + c) * 64 + n];
              WSP(float, WS_MOD)[((size_t)layer * NCOND + c) * NMOD * D + cg * 64 + n] = s2; }
          __syncthreads();
      } }
}

template <int NV> DI void load_mod_row(const float* xr, const float* gp, const float* shp, const float* scp, int lane, f32x4 (&v)[NV]) {
    float ss = 0.f;
#pragma unroll
    for (int j = 0; j < NV; ++j) { v[j] = *(const f32x4*)(xr + (j * 64 + lane) * 4); ss += (v[j].x * v[j].x + v[j].y * v[j].y) + (v[j].z * v[j].z + v[j].w * v[j].w); }
    const float rstd = 1.0f / sqrtf(wave_sum(ss) * (1.0f / D) + EPS);
#pragma unroll
    for (int j = 0; j < NV; ++j) { const int c = (j * 64 + lane) * 4; const f32x4 g = *(const f32x4*)(gp + c), sh = *(const f32x4*)(shp + c), sc = *(const f32x4*)(scp + c);
        v[j] = v[j] * rstd * g * (sc + 1.0f) + sh; }
}
DI const float* x_in_row(const Frame& F, int row) { return row < MC ? F.inp(I_XP) + (size_t)row * D : F.inp(I_XS) + (size_t)(row - MC) * D; }
DI void phase_norm(Frame& F, int layer, int which  , bool first, bool fp8out = false) {
    const int gw = F.bx * NWAVES + F.wave, NGW = F.G * NWAVES; constexpr int NV = D / 256;
    const float* X = F.out; bf16* XN = WSP(bf16, WS_XN);
    const float* gp = F.inp(I_NORMG) + ((size_t)layer * 3 + which) * D;
    f32x4 cur[NV], nxt[NV], gs[NV], sh[NV]; int ccond = -1;
    if (gw < M) {
#pragma unroll
        for (int j = 0; j < NV; ++j) cur[j] = *(const f32x4*)((first ? x_in_row(F, gw) : X + (size_t)gw * D) + (j * 64 + F.lane) * 4); }
    for (int row = gw; row < M; row += NGW) {
        const int nrow = row + NGW < M ? row + NGW : row;
#pragma unroll
        for (int j = 0; j < NV; ++j) nxt[j] = *(const f32x4*)((first ? x_in_row(F, nrow) : X + (size_t)nrow * D) + (j * 64 + F.lane) * 4);
        const int cond = cond_of_row(row);
        if (cond != ccond) { ccond = cond; const float* mp = WSP(float, WS_MOD) + (((size_t)layer * NCOND + cond) * NMOD + 3 * which) * D;
#pragma unroll
            for (int j = 0; j < NV; ++j) { const int c = (j * 64 + F.lane) * 4; gs[j] = *(const f32x4*)(gp + c) * (*(const f32x4*)(mp + D + c) + 1.0f); sh[j] = *(const f32x4*)(mp + c); } }
        float ss = 0.f;
#pragma unroll
        for (int j = 0; j < NV; ++j) ss += (cur[j].x * cur[j].x + cur[j].y * cur[j].y) + (cur[j].z * cur[j].z + cur[j].w * cur[j].w);
        const float rstd = 1.0f / sqrtf(wave_sum(ss) * (1.0f / D) + EPS);
#pragma unroll
        for (int j = 0; j < NV; ++j) { const f32x4 v = cur[j] * rstd * gs[j] + sh[j];
            if (fp8out) *(unsigned*)((unsigned char*)XN + (size_t)row * D + (j * 64 + F.lane) * 4) = pk4_fp8(v.x, v.y, v.z, v.w);
            else { u32x2 w; w.x = pk2(v.x, v.y); w.y = pk2(v.z, v.w); *(u32x2*)(XN + (size_t)row * D + (j * 64 + F.lane) * 4) = w; }
            cur[j] = nxt[j]; }
    }
}
DI float row_rstd(const float* xr, int lane) {
    float ss = 0.f;
#pragma unroll
    for (int j = 0; j < D / 256; ++j) { const f32x4 v = *(const f32x4*)(xr + (j * 64 + lane) * 4); ss += (v.x * v.x + v.y * v.y) + (v.z * v.z + v.w * v.w); }
    return 1.0f / sqrtf(wave_sum(ss) * (1.0f / D) + EPS);
}
DI void phase_norm_rwkv(Frame& F, int layer) {
    const int gw = F.bx * NWAVES + F.wave, NGW = F.G * NWAVES;
    const float* X = F.out; bf16* XS = WSP(bf16, WS_XN);
    const float* gp = F.inp(I_NORMG) + ((size_t)layer * 3 + 1) * D; const float* mu = F.inp(I_RMU);
    for (int row = gw; row < M; row += NGW) {
        const float* mp = WSP(float, WS_MOD) + (((size_t)layer * NCOND + cond_of_row(row)) * NMOD + 3) * D;
        const int t = row < MC ? row % TC : (row - MC) % TL, T = row < MC ? TC : TL;
        const bool hasm = t > 0, hasp = t < T - 1;
        const float* x0 = X + (size_t)row * D; const float* xm = hasm ? x0 - D : x0; const float* xp = hasp ? x0 + D : x0;
        const float r0 = row_rstd(x0, F.lane), rm = hasm ? row_rstd(xm, F.lane) : 0.f, rp = hasp ? row_rstd(xp, F.lane) : 0.f;
#pragma unroll 1
        for (int j = 0; j < D / 256; ++j) { const int c = (j * 64 + F.lane) * 4;
            const f32x4 g = *(const f32x4*)(gp + c), sh = *(const f32x4*)(mp + c), sc = *(const f32x4*)(mp + D + c) + 1.0f;
            const f32x4 gs = g * sc;
            const f32x4 h0 = *(const f32x4*)(x0 + c) * r0 * gs + sh;
            const f32x4 hm = hasm ? *(const f32x4*)(xm + c) * rm * gs + sh : (f32x4){0.f, 0.f, 0.f, 0.f};
            const f32x4 hp = hasp ? *(const f32x4*)(xp + c) * rp * gs + sh : (f32x4){0.f, 0.f, 0.f, 0.f};
            const f32x4 cs = (hm + hp) * 0.5f - h0;
#pragma unroll
            for (int p = 0; p < 6; ++p) { const f32x4 m = *(const f32x4*)(mu + (size_t)p * D + c); const f32x4 o = h0 + cs * m;
                u32x2 w; w.x = pk2(o.x, o.y); w.y = pk2(o.z, o.w); *(u32x2*)(XS + ((size_t)p * M + row) * D + c) = w; } }
    }
}

DI void phase_qknorm(Frame& F, int slot) {
    const int gw = F.bx * NWAVES + F.wave, NGW = F.G * NWAVES;
    bf16* QKV = WSP(bf16, WS_QKV); bf16* KB = WSP(bf16, WS_KB); bf16* VB = WSP(bf16, WS_VB); const float* rope = WSP(float, WS_ROPE);
    const float* qn = F.inp(I_AQN) + (size_t)slot * HD; const float* kn = F.inp(I_AKN) + (size_t)slot * HD;
    const int e0 = 2 * F.lane; const float qn0 = qn[e0], qn1 = qn[e0 + 1], kn0 = kn[e0], kn1 = kn[e0 + 1];
    for (int row = gw; row < M; row += NGW) {
        const bool lat = row >= MC; const int t = lat ? (row - MC) % TL : row % TC, b = lat ? (row - MC) / TL : row / TC;
        float c0 = 1.f, s0 = 0.f, c1 = 1.f, s1 = 0.f;
        if (lat) { const int pos = (e0 >> 6) ? (t % GRIDW) : (t / GRIDW); const float* rp = rope + ((size_t)pos * 32 + (e0 & 31)) * 2; c0 = rp[0]; s0 = rp[1]; c1 = rp[2]; s1 = rp[3];
            if ((e0 & 63) < 32) { s0 = -s0; s1 = -s1; } }
        for (int hh = 0; hh < AH + 2 * AKV; ++hh) {
            const unsigned w = *(const unsigned*)(QKV + (size_t)row * QKVD + hh * HD + e0); float x0 = bflo(w), x1 = bfhi(w);
            if (hh < AH + AKV) {
                const float rstd = 1.0f / sqrtf(wave_sum(x0 * x0 + x1 * x1) * (1.0f / HD) + EPS);
                x0 *= rstd * (hh < AH ? qn0 : kn0); x1 *= rstd * (hh < AH ? qn1 : kn1);
                const float p0 = __shfl_xor(x0, 16), p1 = __shfl_xor(x1, 16);
                if (lat) { x0 = x0 * c0 + p0 * s0; x1 = x1 * c1 + p1 * s1; }
                if (hh < AH) *(unsigned*)(QKV + (size_t)row * QKVD + hh * HD + e0) = pk2(x0, x1);
                else { const int kvh = hh - AH; *(unsigned*)(KB + (size_t)row * (AKV * HD) + kvh * HD + e0) = pk2(x0, x1);
                    if (!lat) NT_ST((f32x2*)(F.out + O_CK + ((((size_t)b * NSLOT_ATTN + slot) * TC + t) * AKV + kvh) * HD + e0), ((f32x2){x0, x1})); }
            } else { const int kvh = hh - AH - AKV; *(unsigned*)(VB + (size_t)row * (AKV * HD) + kvh * HD + e0) = w;
                if (!lat) NT_ST((f32x2*)(F.out + O_CV + ((((size_t)b * NSLOT_ATTN + slot) * TC + t) * AKV + kvh) * HD + e0), ((f32x2){x0, x1})); }
        }
    }
}

constexpr int ATT_KS = 136, ATT_VS = 144;
#ifdef HIPEMU
DI u32x2 lds_read_tr16(const bf16* p) {
    emu::WaveX& w = emu::wavex[emu::wave_id()]; const int lane = threadIdx.x & 63; memcpy(w.slot[lane], &p, sizeof(p)); emu::wave_bar();
    const int g = lane >> 4, i = lane & 15; unsigned short e[4];
    for (int q = 0; q < 4; ++q) { const bf16* a; memcpy(&a, w.slot[16 * g + 4 * q + (i >> 2)], sizeof(a)); e[q] = a[i & 3]; }
    emu::wave_bar(); u32x2 r; r.x = e[0] | ((unsigned)e[1] << 16); r.y = e[2] | ((unsigned)e[3] << 16); return r;
}
#else
typedef short v4i16_t __attribute__((ext_vector_type(4)));
DI u32x2 lds_read_tr16(const LAS bf16* p) { return __builtin_bit_cast(u32x2, __builtin_amdgcn_ds_read_tr16_b64_v4i16((LAS v4i16_t*)p)); }
#endif
struct AttnRegs { unsigned kw[2][4], vw[2][4]; };
DI void attn_fetch(AttnRegs& R, int tid, const bf16* kb, const bf16* vb, int ldb, const float* kf, const float* vf, int ldf) {
#pragma unroll
    for (int i = 0; i < 2; ++i) { const int c = tid + NTHR * i, key = c >> 4, c8 = (c & 15) * 8;
        if (kb) { const u32x4 a = *(const u32x4*)(kb + (size_t)key * ldb + c8), b = *(const u32x4*)(vb + (size_t)key * ldb + c8);
            R.kw[i][0] = a.x; R.kw[i][1] = a.y; R.kw[i][2] = a.z; R.kw[i][3] = a.w; R.vw[i][0] = b.x; R.vw[i][1] = b.y; R.vw[i][2] = b.z; R.vw[i][3] = b.w; }
        else { const f32x4 a0 = *(const f32x4*)(kf + (size_t)key * ldf + c8), a1 = *(const f32x4*)(kf + (size_t)key * ldf + c8 + 4), b0 = *(const f32x4*)(vf + (size_t)key * ldf + c8), b1 = *(const f32x4*)(vf + (size_t)key * ldf + c8 + 4);
            R.kw[i][0] = pk2(a0.x, a0.y); R.kw[i][1] = pk2(a0.z, a0.w); R.kw[i][2] = pk2(a1.x, a1.y); R.kw[i][3] = pk2(a1.z, a1.w);
            R.vw[i][0] = pk2(b0.x, b0.y); R.vw[i][1] = pk2(b0.z, b0.w); R.vw[i][2] = pk2(b1.x, b1.y); R.vw[i][3] = pk2(b1.z, b1.w); } }
}
DI void attn_stash(const AttnRegs& R, int tid, LAS bf16* Ks, LAS bf16* Vt) {
#pragma unroll
    for (int i = 0; i < 2; ++i) { const int c = tid + NTHR * i, key = c >> 4, c8 = (c & 15) * 8;
        *(LAS u32x4*)(Ks + key * ATT_KS + c8) = (u32x4){R.kw[i][0], R.kw[i][1], R.kw[i][2], R.kw[i][3]};
        *(LAS u32x4*)(Vt + key * ATT_VS + c8) = (u32x4){R.vw[i][0], R.vw[i][1], R.vw[i][2], R.vw[i][3]}; }
}
DI void phase_attn(Frame& F, int slot) {
    LAS bf16* Ks = (LAS bf16*)F.lds; LAS bf16* Vt = (LAS bf16*)(F.lds + 64 * ATT_KS * 2);
    const bf16* QKV = WSP(bf16, WS_QKV); const bf16* KB = WSP(bf16, WS_KB); const bf16* VB = WSP(bf16, WS_VB); bf16* OB = WSP(bf16, WS_OB);
    const float* sink = F.inp(I_ASINK) + (size_t)slot * AH;
    constexpr int U_LAT = BL * AH * (TL / 128), U_CTX = BC * AH * (TC / 128);
    const int l15 = F.lane & 15, kq = F.lane >> 4; const float scale = 0.08838834764831845f;
    for (int ui = F.bx; ui < U_LAT + U_CTX; ui += F.G) {
        const bool lat = ui < U_LAT; int r = lat ? ui : ui - U_LAT; const int T = lat ? TL : TC, nqt = T / 128;
        const int qt = r % nqt; r /= nqt; const int h = r % AH, b = r / AH, kvh = h / AG;
        const int rowbase = lat ? MC + b * TL : b * TC, t0 = qt * 128, tq = t0 + 16 * F.wave + l15;
        bf16x8 qf[4];
#pragma unroll
        for (int ks = 0; ks < 4; ++ks) qf[ks] = *(const bf16x8*)(QKV + (size_t)(rowbase + tq) * QKVD + h * HD + ks * 32 + kq * 8);
        float m_run = sink[h], l_run = kq == 0 ? 1.0f : 0.0f;
        f32x4 o[8];
#pragma unroll
        for (int dt = 0; dt < 8; ++dt) o[dt] = (f32x4){0.f, 0.f, 0.f, 0.f};
        const int w_lo = lat ? (t0 - 128 > 0 ? t0 - 128 : 0) : 0, w_hi = lat ? (t0 + 256 < TL ? t0 + 256 : TL) : TC;
        const int n_win = (w_hi - w_lo) / 64, n_tiles = n_win + (lat ? PAST / 64 : 0);
        AttnRegs R;
#define ATT_FETCH(ti_) do { const bool win_ = (ti_) < n_win; const int k0_ = win_ ? w_lo + (ti_) * 64 : ((ti_) - n_win) * 64; \
            if (win_) attn_fetch(R, F.tid, KB + (size_t)(rowbase + k0_) * (AKV * HD) + kvh * HD, VB + (size_t)(rowbase + k0_) * (AKV * HD) + kvh * HD, AKV * HD, nullptr, nullptr, 0); \
            else { const size_t off_ = ((((size_t)b * NSLOT_ATTN + slot) * PAST + k0_) * AKV + kvh) * HD; attn_fetch(R, F.tid, nullptr, nullptr, 0, F.inp(I_CK) + off_, F.inp(I_CV) + off_, AKV * HD); } } while (0)
        ATT_FETCH(0);
        for (int ti = 0; ti < n_tiles; ++ti) {
            const bool win = ti < n_win; const int k0 = win ? w_lo + ti * 64 : (ti - n_win) * 64;
            __syncthreads();
            attn_stash(R, F.tid, Ks, Vt);
            if (ti + 1 < n_tiles) ATT_FETCH(ti + 1);
            __syncthreads();
            f32x4 s[4];
#pragma unroll
            for (int kt = 0; kt < 4; ++kt) { s[kt] = (f32x4){0.f, 0.f, 0.f, 0.f};
#pragma unroll
                for (int ks = 0; ks < 4; ++ks) { const bf16x8 a = *(const LAS bf16x8*)(Ks + (kt * 16 + l15) * ATT_KS + ks * 32 + kq * 8);
                    s[kt] = __builtin_amdgcn_mfma_f32_16x16x32_bf16(a, qf[ks], s[kt], 0, 0, 0); } }
            float tmax = -3.0e38f;
#pragma unroll
            for (int kt = 0; kt < 4; ++kt)
#pragma unroll
                for (int j = 0; j < 4; ++j) { float v = s[kt][j] * scale;
                    if (lat && win) { const int tk = k0 + kt * 16 + kq * 4 + j; const int d = tq - tk; if (d > 128 || d < -128) v = -1.0e30f; }
                    s[kt][j] = v; tmax = fmaxf(tmax, v); }
            tmax = fmaxf(tmax, __shfl_xor(tmax, 16)); tmax = fmaxf(tmax, __shfl_xor(tmax, 32));
            const float m_new = fmaxf(m_run, tmax), alpha = __expf(m_run - m_new); m_run = m_new;
            float psum = 0.f;
#pragma unroll
            for (int kt = 0; kt < 4; ++kt)
#pragma unroll
                for (int j = 0; j < 4; ++j) { const float p = __expf(s[kt][j] - m_new); s[kt][j] = p; psum += p; }
            l_run = l_run * alpha + psum;
#pragma unroll
            for (int dt = 0; dt < 8; ++dt) o[dt] *= alpha;
#pragma unroll
            for (int ks = 0; ks < 2; ++ks) {
                u32x4 pw; pw.x = pk2(s[2 * ks][0], s[2 * ks][1]); pw.y = pk2(s[2 * ks][2], s[2 * ks][3]); pw.z = pk2(s[2 * ks + 1][0], s[2 * ks + 1][1]); pw.w = pk2(s[2 * ks + 1][2], s[2 * ks + 1][3]);
                bf16x8 pb; __builtin_memcpy(&pb, &pw, 16);
#pragma unroll
                for (int dt = 0; dt < 8; ++dt) { const LAS bf16* vp = Vt + (kq * 4 + (l15 >> 2)) * ATT_VS + dt * 16 + 4 * (l15 & 3);
                    const u32x2 v0 = lds_read_tr16(vp + (2 * ks) * 16 * ATT_VS), v1 = lds_read_tr16(vp + (2 * ks + 1) * 16 * ATT_VS);
                    u32x4 vw = (u32x4){v0.x, v0.y, v1.x, v1.y}; bf16x8 va; __builtin_memcpy(&va, &vw, 16);
                    o[dt] = __builtin_amdgcn_mfma_f32_16x16x32_bf16(va, pb, o[dt], 0, 0, 0); }
            }
        }
        l_run += __shfl_xor(l_run, 16); l_run += __shfl_xor(l_run, 32);
        const float inv = 1.0f / l_run;
        bf16* orow = OB + (size_t)(rowbase + tq) * D + h * HD + kq * 4;
#pragma unroll
        for (int dt = 0; dt < 8; ++dt) { u32x2 w; w.x = pk2(o[dt][0] * inv, o[dt][1] * inv); w.y = pk2(o[dt][2] * inv, o[dt][3] * inv); *(u32x2*)(orow + dt * 16) = w; }
    }
    __syncthreads();
}

constexpr int ML_QS = 136, ML_SS = 72;
DI float log_sigmoidf_(float x) { return x < 0.f ? x - log1pf(__expf(x)) : -log1pf(__expf(-x)); }
DI float oct_sum(float v) {
#ifdef HIPEMU
    v += __shfl_xor(v, 1); v += __shfl_xor(v, 2); v += __shfl_xor(v, 4); return v;
#else
#define DPP_ADD(ctrl) v += __builtin_bit_cast(float, __builtin_amdgcn_update_dpp(0, __builtin_bit_cast(int, v), ctrl, 0xF, 0xF, true))
    DPP_ADD(0xB1); DPP_ADD(0x4E); DPP_ADD(0x141); return v;
#undef DPP_ADD
#endif
}
DI float row16_sum_(float v) {
#ifdef HIPEMU
    v += __shfl_xor(v, 1); v += __shfl_xor(v, 2); v += __shfl_xor(v, 4); v += __shfl_xor(v, 8); return v;
#else
#define DPP_ADD(ctrl) v += __builtin_bit_cast(float, __builtin_amdgcn_update_dpp(0, __builtin_bit_cast(int, v), ctrl, 0xF, 0xF, true))
    DPP_ADD(0xB1); DPP_ADD(0x4E); DPP_ADD(0x141); DPP_ADD(0x140); return v;
#undef DPP_ADD
#endif
}
DI void phase_mlstm_scan(Frame& F) {
    constexpr int NCM = TL / 64 > TC / 64 ? TL / 64 : TC / 64;
    LAS bf16* Qs = (LAS bf16*)F.lds;
    LAS bf16* Ks = Qs + 64 * ML_QS;
    LAS bf16* Kw = Ks + 64 * ML_QS;
    LAS bf16* Vt = Kw + 128 * ML_SS;
    LAS bf16* Ct = Vt + 64 * ML_SS;
    LAS bf16* Sp = Ct + 64 * ML_QS;
    LAS float* fa = (LAS float*)(Sp + 64 * ML_SS);
    LAS float* a_n = fa, *a_rs = fa + 128, *a_qn = fa + 256;
    LAS float* g_bc = fa + 320, *g_ib = g_bc + NCM * 64, *g_mc = g_ib + NCM * 64, *g_av = g_mc + NCM * 64, *g_wg = g_av + NCM * 64;
    LAS float* g_bl = g_wg + NCM * 64, *g_pml = g_bl + NCM, *g_m = g_pml + NCM, *g_dec = g_m + NCM + 1;
    const bf16* P = WSP(bf16, WS_MPROJ); const float* Gt = WSP(float, WS_GATES); bf16* HD_ = WSP(bf16, WS_HDIR);
    const int l15 = F.lane & 15, kq = F.lane >> 4; const float scale = 0.08838834764831845f;
    constexpr int I_LAT = BL * MH * 2 * 4, I_CTX = BC * MH * 2 * 4;
    for (int it = F.bx; it < I_LAT + I_CTX; it += F.G) {
        const bool lat = it < I_LAT; int r = lat ? it : it - I_LAT;
        const int dvq = r & 3; r >>= 2; const int dir = r & 1; r >>= 1; const int h = r % MH, b = r / MH;
        const int T = lat ? TL : TC, rowbase = lat ? MC + b * TL : b * TC, nc = T / 64;
        __syncthreads();
        for (int c = F.wave; c < nc; c += NWAVES) { const int s = F.lane, tau = 64 * c + s, t = dir ? T - 1 - tau : tau; const float* g = Gt + (size_t)(rowbase + t) * NGATE;
            const float ipre = g[(2 * dir) * MH + h], lf = log_sigmoidf_(g[(2 * dir + 1) * MH + h]);
            float bc = lf;
#pragma unroll
            for (int o = 1; o < 64; o <<= 1) { const float u = __shfl_up(bc, o); if (s >= o) bc += u; }
            const float ib = ipre - bc; float pm = ib;
#pragma unroll
            for (int o = 1; o < 64; o <<= 1) { const float u = __shfl_up(pm, o); if (s >= o) pm = fmaxf(pm, u); }
            g_bc[c * 64 + s] = bc; g_ib[c * 64 + s] = ib; g_mc[c * 64 + s] = pm;
            if (s == 63) { g_bl[c] = bc; g_pml[c] = pm; } }
        f32x4 Cacc[4];
#pragma unroll
        for (int dvt = 0; dvt < 4; ++dvt)
#pragma unroll
            for (int j = 0; j < 4; ++j) { const int dk = 16 * F.wave + 4 * kq + j, dv = dvq * 64 + 16 * dvt + l15;
                Cacc[dvt][j] = lat ? F.inp(I_MC)[((((size_t)b * 2 + dir) * MH + h) * MDK + dk) * MDV + dv] : 0.f; }
        if (F.tid < MDK) a_n[F.tid] = lat ? F.inp(I_MN)[(((size_t)b * 2 + dir) * MH + h) * MDK + F.tid] : 0.f;
#pragma unroll
        for (int dvt = 0; dvt < 4; ++dvt) { u32x2 w; w.x = pk2(Cacc[dvt][0], Cacc[dvt][1]); w.y = pk2(Cacc[dvt][2], Cacc[dvt][3]); *(LAS u32x2*)(Ct + (16 * dvt + l15) * ML_QS + 16 * F.wave + 4 * kq) = w; }
        __syncthreads();
        if (F.tid == 0) { float m = lat ? F.inp(I_MM)[((size_t)b * 2 + dir) * MH + h] : 0.f;
            for (int c = 0; c < nc; ++c) { g_m[c] = m; const float bl = g_bl[c], mn = bl + fmaxf(m, g_pml[c]); g_dec[c] = __expf(bl + m - mn); m = mn; }
            g_m[nc] = m; }
        __syncthreads();
        for (int i = F.tid; i < nc * 64; i += NTHR) { const int c = i >> 6; const float mprev = g_m[c], bc = g_bc[i], pm = g_mc[i];
            const float mcv = bc + fmaxf(mprev, pm); g_mc[i] = mcv; g_av[i] = __expf(bc + mprev - mcv); g_wg[i] = __expf(g_bl[c] + g_ib[i] - g_m[c + 1]); }
        u32x4 rq0, rq1, rk0, rk1, rv0;
#define ML_FETCH(c_) do { const int s_ = F.tid & 63, pc_ = F.tid >> 6; const int tau_ = 64 * (c_) + s_, t_ = dir ? T - 1 - tau_ : tau_; const bf16* prow_ = P + (size_t)(rowbase + t_) * MIN; \
            rq0 = *(const u32x4*)(prow_ + h * MDK + pc_ * 16); rq1 = *(const u32x4*)(prow_ + h * MDK + pc_ * 16 + 8); \
            rk0 = *(const u32x4*)(prow_ + MH * MDK + h * MDK + pc_ * 16); rk1 = *(const u32x4*)(prow_ + MH * MDK + h * MDK + pc_ * 16 + 8); \
            rv0 = *(const u32x4*)(prow_ + 2 * MH * MDK + h * MDV + dvq * 64 + pc_ * 8); } while (0)
        ML_FETCH(0);
        for (int c = 0; c < nc; ++c) {
            if (c > 0) { const float decay = g_dec[c - 1];
                if (F.tid < MDK) { float sm = 0.f;
#pragma unroll 8
                    for (int e = 0; e < 64; ++e) sm += bf2f(Kw[F.tid * ML_SS + e]);
                    a_n[F.tid] = decay * a_n[F.tid] + sm; }
#pragma unroll
                for (int dvt = 0; dvt < 4; ++dvt) { u32x2 w; w.x = pk2(Cacc[dvt][0], Cacc[dvt][1]); w.y = pk2(Cacc[dvt][2], Cacc[dvt][3]); *(LAS u32x2*)(Ct + (16 * dvt + l15) * ML_QS + 16 * F.wave + 4 * kq) = w; } }
            { const int s = F.tid & 63, pc = F.tid >> 6;
              *(LAS u32x4*)(Qs + s * ML_QS + pc * 16) = rq0; *(LAS u32x4*)(Qs + s * ML_QS + pc * 16 + 8) = rq1;
              *(LAS u32x4*)(Ks + s * ML_QS + pc * 16) = rk0; *(LAS u32x4*)(Ks + s * ML_QS + pc * 16 + 8) = rk1;
              const unsigned vw[4] = {rv0.x, rv0.y, rv0.z, rv0.w};
#pragma unroll
              for (int e = 0; e < 4; ++e) { Vt[(pc * 8 + 2 * e) * ML_SS + s] = (bf16)(vw[e] & 0xffffu); Vt[(pc * 8 + 2 * e + 1) * ML_SS + s] = (bf16)(vw[e] >> 16); } }
            if (c + 1 < nc) ML_FETCH(c + 1);
            __syncthreads();
            const LAS float* a_bcum = g_bc + c * 64, *a_ib = g_ib + c * 64, *a_mc = g_mc + c * 64, *a_av = g_av + c * 64, *a_wg = g_wg + c * 64;
            { const int s = F.tid & 63, pc = F.tid >> 6; const float wg = a_wg[s];
#pragma unroll
              for (int e = 0; e < 16; ++e) Kw[(pc * 16 + e) * ML_SS + s] = (bf16)f2bf(wg * bf2f(Ks[s * ML_QS + pc * 16 + e])); }
            { const int tt = F.wave & 3; float rsum[4] = {0.f, 0.f, 0.f, 0.f};
#pragma unroll
              for (int i = 0; i < 2; ++i) { const int st = 2 * (F.wave >> 2) + i; f32x4 acc = (f32x4){0.f, 0.f, 0.f, 0.f};
#pragma unroll
                  for (int ks = 0; ks < 4; ++ks) { const bf16x8 a = *(const LAS bf16x8*)(Qs + (tt * 16 + l15) * ML_QS + ks * 32 + kq * 8), bb = *(const LAS bf16x8*)(Ks + (st * 16 + l15) * ML_QS + ks * 32 + kq * 8);
                      acc = __builtin_amdgcn_mfma_f32_16x16x32_bf16(a, bb, acc, 0, 0, 0); }
                  const int s = st * 16 + l15; const float ibs = a_ib[s];
#pragma unroll
                  for (int j = 0; j < 4; ++j) { const int t = tt * 16 + kq * 4 + j; const float v = s <= t ? acc[j] * scale * __expf(a_bcum[t] - a_mc[t] + ibs) : 0.f;
                      const unsigned vb = f2bf(v); Sp[t * ML_SS + s] = (bf16)vb; rsum[j] += bf2f(vb); } }
#pragma unroll
              for (int j = 0; j < 4; ++j) { const float rs = row16_sum_(rsum[j]); if (l15 == 0) a_rs[(F.wave >> 2) * 64 + tt * 16 + kq * 4 + j] = rs; } }
            { const int t = 8 * F.wave + (F.lane >> 3), part = F.lane & 7; float qn = 0.f;
#pragma unroll
              for (int e = 0; e < 16; ++e) qn += bf2f(Qs[t * ML_QS + part * 16 + e]) * a_n[part * 16 + e];
              qn = oct_sum(qn); if (part == 0) a_qn[t] = qn; }
            __syncthreads();
            { const int tt = F.wave & 3;
#pragma unroll
              for (int i = 0; i < 2; ++i) { const int dvt = 2 * (F.wave >> 2) + i; f32x4 a1 = (f32x4){0.f, 0.f, 0.f, 0.f}, a2 = (f32x4){0.f, 0.f, 0.f, 0.f};
#pragma unroll
                  for (int ks = 0; ks < 2; ++ks) { const bf16x8 a = *(const LAS bf16x8*)(Sp + (tt * 16 + l15) * ML_SS + ks * 32 + kq * 8), bb = *(const LAS bf16x8*)(Vt + (dvt * 16 + l15) * ML_SS + ks * 32 + kq * 8);
                      a1 = __builtin_amdgcn_mfma_f32_16x16x32_bf16(a, bb, a1, 0, 0, 0); }
#pragma unroll
                  for (int ks = 0; ks < 4; ++ks) { const bf16x8 a = *(const LAS bf16x8*)(Qs + (tt * 16 + l15) * ML_QS + ks * 32 + kq * 8), bb = *(const LAS bf16x8*)(Ct + (dvt * 16 + l15) * ML_QS + ks * 32 + kq * 8);
                      a2 = __builtin_amdgcn_mfma_f32_16x16x32_bf16(a, bb, a2, 0, 0, 0); }
#pragma unroll
                  for (int j = 0; j < 4; ++j) { const int t = tt * 16 + kq * 4 + j; const float avs = a_av[t] * scale;
                      const float num = a1[j] + avs * a2[j], den = (a_rs[t] + a_rs[64 + t]) + avs * a_qn[t];
                      const int tau = 64 * c + t, tok = dir ? T - 1 - tau : tau;
                      HD_[((size_t)dir * M + rowbase + tok) * D + h * MDV + dvq * 64 + dvt * 16 + l15] = (bf16)f2bf(num / fmaxf(fabsf(den), __expf(-a_mc[t]))); } } }
            { const float decay = g_dec[c];
#pragma unroll
              for (int dvt = 0; dvt < 4; ++dvt) { Cacc[dvt] *= decay;
#pragma unroll
                  for (int ks = 0; ks < 2; ++ks) { const bf16x8 a = *(const LAS bf16x8*)(Kw + (16 * F.wave + l15) * ML_SS + ks * 32 + kq * 8), bb = *(const LAS bf16x8*)(Vt + (dvt * 16 + l15) * ML_SS + ks * 32 + kq * 8);
                      Cacc[dvt] = __builtin_amdgcn_mfma_f32_16x16x32_bf16(a, bb, Cacc[dvt], 0, 0, 0); } } }
            __syncthreads();
        }
#undef ML_FETCH
        { const float decay = g_dec[nc - 1];
          if (F.tid < MDK) { float sm = 0.f;
#pragma unroll 8
              for (int e = 0; e < 64; ++e) sm += bf2f(Kw[F.tid * ML_SS + e]);
              a_n[F.tid] = decay * a_n[F.tid] + sm; } }
        if (!lat) {
#pragma unroll
            for (int dvt = 0; dvt < 4; ++dvt)
#pragma unroll
                for (int j = 0; j < 4; ++j) { const int dk = 16 * F.wave + 4 * kq + j, dv = dvq * 64 + 16 * dvt + l15;
                    NT_ST(F.out + O_MC + ((((size_t)b * 2 + dir) * MH + h) * MDK + dk) * MDV + dv, Cacc[dvt][j]); }
            if (dvq == 0) { if (F.tid < MDK) F.out[O_MN + (((size_t)b * 2 + dir) * MH + h) * MDK + F.tid] = a_n[F.tid];
                if (F.tid == 0) F.out[O_MM + ((size_t)b * 2 + dir) * MH + h] = g_m[nc]; }
        }
    }
    __syncthreads();
}
DI void phase_mlstm_combine(Frame& F) {
    const int gw = F.bx * NWAVES + F.wave, NGW = F.G * NWAVES;
    const bf16* HD_ = WSP(bf16, WS_HDIR); const bf16* P = WSP(bf16, WS_MPROJ); bf16* OB = WSP(bf16, WS_OB); const float* on = F.inp(I_MON);
    for (int row = gw; row < M; row += NGW)
        for (int h = 0; h < MH; ++h) { const int c = h * MDV + 4 * F.lane;
            const u32x2 hf = *(const u32x2*)(HD_ + (size_t)row * D + c), hb = *(const u32x2*)(HD_ + ((size_t)M + row) * D + c);
            const f32x4 s = (f32x4){bflo(hf.x) + bflo(hb.x), bfhi(hf.x) + bfhi(hb.x), bflo(hf.y) + bflo(hb.y), bfhi(hf.y) + bfhi(hb.y)};
            const float rstd = 1.0f / sqrtf(wave_sum((s.x * s.x + s.y * s.y) + (s.z * s.z + s.w * s.w)) * (1.0f / MDV) + EPS);
            const f32x4 g = *(const f32x4*)(on + c); const u32x2 ow = *(const u32x2*)(P + (size_t)row * MIN + 2 * MH * MDK + D + c);
            u32x2 w; w.x = pk2(sigmoidf_(bflo(ow.x)) * s.x * rstd * g.x, sigmoidf_(bfhi(ow.x)) * s.y * rstd * g.y); w.y = pk2(sigmoidf_(bflo(ow.y)) * s.z * rstd * g.z, sigmoidf_(bfhi(ow.y)) * s.w * rstd * g.w);
            *(u32x2*)(OB + (size_t)row * D + c) = w; }
}

constexpr int RW_TB = 4;
DI float quad_sum(float x) {
#ifdef HIPEMU
    x += __shfl_xor(x, 1); x += __shfl_xor(x, 2); return x;
#else
    x += __builtin_bit_cast(float, __builtin_amdgcn_update_dpp(0, __builtin_bit_cast(int, x), 0xB1, 0xF, 0xF, true));
    x += __builtin_bit_cast(float, __builtin_amdgcn_update_dpp(0, __builtin_bit_cast(int, x), 0x4E, 0xF, 0xF, true));
    return x;
#endif
}
template <int NR> DI void rwkv_task(Frame& F, int task, bool lat) {
    LAS float* slab = (LAS float*)(F.lds + F.wave * (RW_TB * 6 * 64 * 4));
    const bf16* RKV = WSP(bf16, WS_RKV); const float* DEC = WSP(float, WS_DEC); const bf16* AG = WSP(bf16, WS_AG); bf16* YD = WSP(bf16, WS_YDIR);
    constexpr int NPART = 4 / NR;
    int r = task; const int part = r % NPART; r /= NPART; const int dir = r & 1; r >>= 1; const int h = r % RH, b = r / RH;
    const int T = lat ? TL : TC, rowbase = lat ? MC + b * TL : b * TC, col = h * 64 + F.lane;
    const int rgrp = F.lane >> 2, q = F.lane & 3, v0 = part * (16 * NR) + rgrp * NR;
    const float k_k = F.inp(I_RKK)[col], k_a = F.inp(I_RKA)[col];
    f32x2 S[NR][8];
#pragma unroll
    for (int i = 0; i < NR; ++i) {
        if (lat) { const float* sp = F.inp(I_RS) + ((((size_t)b * 2 + dir) * RH + h) * 64 + v0 + i) * 64 + q * 16;
#pragma unroll
            for (int k = 0; k < 4; ++k) { const f32x4 x = *(const f32x4*)(sp + 4 * k); S[i][2 * k] = (f32x2){x.x, x.y}; S[i][2 * k + 1] = (f32x2){x.z, x.w}; } }
        else {
#pragma unroll
            for (int k = 0; k < 8; ++k) S[i][k] = (f32x2){0.f, 0.f}; } }
    const bf16* Rp = RKV + (size_t)rowbase * D + col; const bf16* Kp = Rp + (size_t)M * D; const bf16* Vp = Kp + (size_t)M * D;
    const float* Wp = DEC + ((size_t)dir * M + rowbase) * D + col; const bf16* Ap = AG + ((size_t)dir * M + rowbase) * D + col;
    bf16* Yp = YD + ((size_t)dir * M + rowbase) * D + h * 64 + v0;
    float cr[RW_TB], ck[RW_TB], cv[RW_TB], cw[RW_TB], ca[RW_TB];
#pragma unroll
    for (int i = 0; i < RW_TB; ++i) { const int t = dir ? T - 1 - i : i; cr[i] = bf2f(Rp[(size_t)t * D]); ck[i] = bf2f(Kp[(size_t)t * D]); cv[i] = bf2f(Vp[(size_t)t * D]); cw[i] = Wp[(size_t)t * D]; ca[i] = bf2f(Ap[(size_t)t * D]); }
    for (int g0 = 0; g0 < T; g0 += RW_TB) {
        WSYNC();
#pragma unroll
        for (int i = 0; i < RW_TB; ++i) {
            const float kr = ck[i] * k_k; const float kk = kr * rsqrtf(fmaxf(wave_sum(kr * kr), 1e-24f));
            const float kd = ck[i] * (1.0f + (ca[i] - 1.0f) * k_a);
            LAS float* sl = slab + i * 384 + F.lane;
            sl[0] = kk; sl[64] = cw[i]; sl[128] = kk * ca[i]; sl[192] = kd; sl[256] = cr[i]; sl[320] = cv[i];
        }
        { const int gn = g0 + RW_TB < T ? g0 + RW_TB : g0;
#pragma unroll
          for (int i = 0; i < RW_TB; ++i) { const int tau = gn + i, t = dir ? T - 1 - tau : tau; cr[i] = bf2f(Rp[(size_t)t * D]); ck[i] = bf2f(Kp[(size_t)t * D]); cv[i] = bf2f(Vp[(size_t)t * D]); cw[i] = Wp[(size_t)t * D]; ca[i] = bf2f(Ap[(size_t)t * D]); } }
        WSYNC();
#pragma unroll 1
        for (int i = 0; i < RW_TB; ++i) {
            const int tau = g0 + i, t = dir ? T - 1 - tau : tau;
            const LAS float* sl = slab + i * 384 + q * 16;
            f32x4 xk[4], xw[4], xb[4], xd[4], xr[4];
#pragma unroll
            for (int k4 = 0; k4 < 4; ++k4) xk[k4] = *(const LAS f32x4*)(sl + 4 * k4);
            float vv[NR];
#pragma unroll
            for (int j = 0; j < NR; ++j) vv[j] = slab[i * 384 + 320 + v0 + j];
#pragma unroll
            for (int k4 = 0; k4 < 4; ++k4) { xw[k4] = *(const LAS f32x4*)(sl + 64 + 4 * k4); xb[k4] = *(const LAS f32x4*)(sl + 128 + 4 * k4); xd[k4] = *(const LAS f32x4*)(sl + 192 + 4 * k4); xr[k4] = *(const LAS f32x4*)(sl + 256 + 4 * k4); }
            float ys[NR];
#pragma unroll
            for (int j = 0; j < NR; ++j) {
                f32x2 sa2 = (f32x2){0.f, 0.f}, sb2 = (f32x2){0.f, 0.f};
#pragma unroll
                for (int k4 = 0; k4 < 4; ++k4) { sa2 += S[j][2 * k4] * (f32x2){xk[k4].x, xk[k4].y}; sb2 += S[j][2 * k4 + 1] * (f32x2){xk[k4].z, xk[k4].w}; }
                const f32x2 sc2 = sa2 + sb2; const float nsa = -quad_sum(sc2.x + sc2.y), vj = vv[j];
                f32x2 ya = (f32x2){0.f, 0.f}, yb = (f32x2){0.f, 0.f};
#pragma unroll
                for (int k4 = 0; k4 < 4; ++k4) {
                    const f32x2 wl = (f32x2){xw[k4].x, xw[k4].y}, wh = (f32x2){xw[k4].z, xw[k4].w}, bl = (f32x2){xb[k4].x, xb[k4].y}, bh = (f32x2){xb[k4].z, xb[k4].w};
                    const f32x2 dl = (f32x2){xd[k4].x, xd[k4].y}, dh = (f32x2){xd[k4].z, xd[k4].w}, rl = (f32x2){xr[k4].x, xr[k4].y}, rh = (f32x2){xr[k4].z, xr[k4].w};
                    S[j][2 * k4] = S[j][2 * k4] * wl + (bl * nsa + dl * vj); S[j][2 * k4 + 1] = S[j][2 * k4 + 1] * wh + (bh * nsa + dh * vj);
                    ya += S[j][2 * k4] * rl; yb += S[j][2 * k4 + 1] * rh; }
                const f32x2 yc = ya + yb; ys[j] = quad_sum(yc.x + yc.y);
            }
            if (q == 0) {
#pragma unroll
                for (int j = 0; j < NR; ++j) Yp[(size_t)t * D + j] = (bf16)f2bf(ys[j]); }
        }
    }
    if (!lat) {
#pragma unroll
        for (int i = 0; i < NR; ++i) { float* op = F.out + O_RS + ((((size_t)b * 2 + dir) * RH + h) * 64 + v0 + i) * 64 + q * 16;
#pragma unroll
            for (int k = 0; k < 4; ++k) NT_ST((f32x4*)(op + 4 * k), ((f32x4){S[i][2 * k].x, S[i][2 * k].y, S[i][2 * k + 1].x, S[i][2 * k + 1].y})); } }
    WSYNC();
}
#ifndef RW_NRC
#define RW_NRC 4
#endif
DI void phase_rwkv_scan(Frame& F) {
    const int gw = F.bx * NWAVES + F.wave, NGW = F.G * NWAVES;
    constexpr int T_LAT = BL * RH * 2 * 4, T_CTX = BC * RH * 2 * (4 / RW_NRC);
    const bool bal = (NGW == 2048 && T_LAT == 1024 && (T_CTX == 2048 || T_CTX == 4096));
    constexpr int CPW = T_CTX / 1024;
    const int n_lat = bal ? (F.wave < 4 ? 1 : 0) : (gw < T_LAT ? (T_LAT - 1 - gw) / NGW + 1 : 0);
    const int n_ctx = bal ? (F.wave < 4 ? 0 : CPW) : (gw < T_CTX ? (T_CTX - 1 - gw) / NGW + 1 : 0);
#ifndef HIPEMU
    if (bal && F.wave < 4) __builtin_amdgcn_s_setprio(2);
#endif
#pragma unroll 1
    for (int n = 0; n < n_lat + n_ctx; ++n) {
        if (n < n_lat) rwkv_task<1>(F, bal ? F.bx * 4 + F.wave : gw + n * NGW, true);
        else { const int m = n - n_lat; rwkv_task<RW_NRC>(F, bal ? (F.bx * 4 + (F.wave - 4)) * CPW + m : gw + m * NGW, false); }
    }
#ifndef HIPEMU
    __builtin_amdgcn_s_setprio(0);
#endif
}
DI float row16_sum(float v) {
#ifdef HIPEMU
    v += __shfl_xor(v, 1); v += __shfl_xor(v, 2); v += __shfl_xor(v, 4); v += __shfl_xor(v, 8); return v;
#else
#define DPP_ADD(ctrl) v += __builtin_bit_cast(float, __builtin_amdgcn_update_dpp(0, __builtin_bit_cast(int, v), ctrl, 0xF, 0xF, true))
    DPP_ADD(0xB1); DPP_ADD(0x4E); DPP_ADD(0x141); DPP_ADD(0x140); return v;
#undef DPP_ADD
#endif
}
DI f32x4 ld_bf4(const bf16* p) { const u32x2 w = *(const u32x2*)p; return (f32x4){bflo(w.x), bfhi(w.x), bflo(w.y), bfhi(w.y)}; }
DI void phase_rwkv_combine(Frame& F) {
    const int gw = F.bx * NWAVES + F.wave, NGW = F.G * NWAVES;
    const bf16* RKV = WSP(bf16, WS_RKV); const bf16* AG = WSP(bf16, WS_AG); const bf16* YD = WSP(bf16, WS_YDIR); bf16* OB = WSP(bf16, WS_OB);
    const float* lng = F.inp(I_RLNG); const float* lnb = F.inp(I_RLNB); const float* rk = F.inp(I_RRK); const float* kaw = F.inp(I_RKA);
    for (int row = gw; row < M; row += NGW)
#pragma unroll 2
        for (int c = 4 * F.lane; c < D; c += 256) { const size_t o = (size_t)row * D + c;
            const f32x4 y = ld_bf4(YD + o) + ld_bf4(YD + (size_t)M * D + o);
            const float mean = row16_sum((y.x + y.y) + (y.z + y.w)) * (1.0f / 64.0f); const f32x4 d = y - mean;
            const float var = row16_sum((d.x * d.x + d.y * d.y) + (d.z * d.z + d.w * d.w)) * (1.0f / 64.0f);
            const f32x4 yn = d * (1.0f / sqrtf(var + GN_EPS)) * *(const f32x4*)(lng + c) + *(const f32x4*)(lnb + c);
            const f32x4 rr = ld_bf4(RKV + o), kk = ld_bf4(RKV + (size_t)M * D + o), vv = ld_bf4(RKV + (size_t)2 * M * D + o), a0 = ld_bf4(AG + o), a1 = ld_bf4(AG + (size_t)M * D + o), g = ld_bf4(AG + (size_t)2 * M * D + o);
            const f32x4 ka = *(const f32x4*)(kaw + c); const f32x4 t = rr * kk * *(const f32x4*)(rk + c) * (((a0 - 1.0f) * ka + 1.0f) + ((a1 - 1.0f) * ka + 1.0f));
            const float bonus = row16_sum((t.x + t.y) + (t.z + t.w));
            const f32x4 out = (yn + vv * bonus) * g;
            u32x2 w; w.x = pk2(out.x, out.y); w.y = pk2(out.z, out.w); *(u32x2*)(OB + o) = w; }
}

constexpr int NPH = 1 + 9 * 8;
#ifdef HIPEMU
#define KERNEL_LDS() (emu_lds())
#else
#define KERNEL_LDS() ((LAS unsigned char*)lds_raw)
#endif
#define XN WSP(bf16, WS_XN)
#define OB WSP(bf16, WS_OB)
#define MOD WSP(float, WS_MOD)
#ifndef PH_MASK
#define PH_MASK 0xffffffffu
#endif
#define EN(g) (((PH_MASK) >> (g)) & 1u)
__global__ void __launch_bounds__(NTHR, 2) hybrid_fwd(Args args) {
#ifndef HIPEMU
    extern __shared__ __attribute__((aligned(16))) unsigned char lds_raw[];
#endif
    Frame F;
    F.lds = KERNEL_LDS();
    F.tid = threadIdx.x; F.lane = F.tid & 63; F.wave = __builtin_amdgcn_readfirstlane(F.tid >> 6); F.G = gridDim.x; F.bx = blockIdx.x;
#ifdef HIPEMU
    F.ap = &args;
#else
    F.ap = (ArgsP)__builtin_amdgcn_kernarg_segment_ptr();
#endif
    F.refresh();
    for (int u = F.tid; u < (LDS_BYTES - LDSCTL_OFF) / 4; u += NTHR) ((LAS unsigned*)(F.lds + LDSCTL_OFF))[u] = 0u;
    __syncthreads();
#ifndef HIPEMU
    XcdBarrier bar = xcd_barrier_post((unsigned*)(F.ws + WS_CTL) + CW_BAR, (volatile LAS unsigned*)(F.lds + MISC_OFF) + 8);
#else
    XcdBarrier bar{0};
#endif
    const int lo = F.ap->ph_lo, hi = F.ap->ph_hi; bool first = true;
#ifndef BAR_DUP
#define BAR_DUP 0
#endif
#define PH(id) if (lo <= (id) && (id) < hi && (first ? (first = false, true) : (xcd_barrier(bar), (BAR_DUP ? (xcd_barrier(bar), 0) : 0), true)) && (F.refresh(), true) && (PHMARK(id), true))
#ifdef HIPEMU
#define OPAQUE_S(x) do { } while (0)
#define PHMARK(id) 0
#else
#define OPAQUE_S(x) asm volatile("" : "+s"(x))
#define PHMARK(id) ({ asm volatile("; PHASE_MARK " #id); 0; })
#endif
#ifndef REP_MASK
#define REP_MASK 0u
#endif
#ifndef PROBE_PSKIP
#define PROBE_PSKIP 0
#endif
#ifndef PROBE_SAMEUNIT
#define PROBE_SAMEUNIT 0
#endif
#ifndef PROBE_HALFK
#define PROBE_HALFK 0
#endif
#ifndef PROBE_SKIPEPI
#define PROBE_SKIPEPI 0
#endif
#define NREP(g) ((((REP_MASK) >> (g)) & 1u) ? 2 : 1)
#define RP(g, id) if (EN(g)) PH(id) for (int rep = 0, nrep = opq(NREP(g)); rep < nrep; ++rep) if (rep == 0 || (xcd_barrier(bar), true))
#define SPLIT_CNT(id) ((unsigned*)(F.ws + WS_CTL + 65536) + (size_t)(id) * 2048)
#ifndef ALIGN_MASK
#define ALIGN_MASK 0xffffffffu
#endif
#ifndef SPLIT4_MASK
#define SPLIT4_MASK 0u
#endif
#define GEMM_SPLIT_T(EpiT, MapT, mapinit, ntK_, Einit, id, kind, fp8_) { OrderSplit<MapT> S{mapinit, ntK_, F.G, F.bx, (int)(((SPLIT4_MASK) >> (kind)) & 1u)}; EpiSplit<EpiT> E{Einit, WSP(float, WS_SLAB), SPLIT_CNT(id), S.nprod_per_unit(), rep ? PROBE_PSKIP : 0}; \
        pg8::gemm_phase<EpiSplit<EpiT>, OrderSplit<MapT>, ((ALIGN_MASK >> (kind)) & 1u) != 0, true, fp8_>(F.lds, g, S, E); }
#define GEMM_SPLIT(EpiT, MapT, mapinit, ntK_, Einit, id, kind) GEMM_SPLIT_T(EpiT, MapT, mapinit, ntK_, Einit, id, kind, false)
#define GEMM_RESID_T(a_off, b_off, K_, gate_idx, gs_, id, xfirst, fp8_) { pg8::Gemm g{WSP(bf16, a_off), WSP(bf16, b_off), M, D, K_}; \
        GEMM_SPLIT_T(EpiResid, MapSimple, (MapSimple{NM, D / 256, 0}), (K_) / 64, (EpiResid{F.out, MOD + (size_t)(gate_idx) * D, rep ? 0.0f : gs_, rep && PROBE_SKIPEPI, (xfirst) ? F.inp(I_XP) : nullptr, (xfirst) ? F.inp(I_XS) : nullptr}), id, 3, fp8_) }
#define GEMM_RESID(a_off, b_off, K_, gate_idx, gs_, id, xfirst) GEMM_RESID_T(a_off, b_off, K_, gate_idx, gs_, id, xfirst, false)
    RP(0, 0) { p0_prologue(F); }
    for (int hl = 0; hl < 8; ++hl) {
        const int layer = hl >> 1, j = hl & 1, base = 1 + 9 * hl;
        RP(1, base + 0) { phase_norm(F, layer, j ? 2 : 0, hl == 0, hl >= FFN_IN_FP8_FROM); }
        if (hl >= FFN_IN_FP8_FROM) { RP(2, base + 1) { pg8::Gemm g{XN, WSP(bf16, WS_WFI + (size_t)hl * SZ_WFI), M, 2 * DFF, D / 2}; GEMM_SPLIT_T(EpiSwiglu8, MapSimple, (MapSimple{NM, 2 * DFF / 256, 0}), D / 128, (EpiSwiglu8{WSP(bf16, WS_H), rep && PROBE_SKIPEPI}), base + 1, 2, true) } }
        else
        RP(2, base + 1) { pg8::Gemm g{XN, WSP(bf16, WS_WFI + (size_t)hl * SZ_WFI), M, 2 * DFF, D}; GEMM_SPLIT(EpiSwiglu, MapSimple, (MapSimple{NM, 2 * DFF / 256, rep && PROBE_SAMEUNIT}), (rep && PROBE_HALFK) ? D / 128 : D / 64, (EpiSwiglu{WSP(bf16, WS_H), rep && PROBE_SKIPEPI}), base + 1, 2) }
#if FFN_OUT_FP8
        RP(3, base + 2) GEMM_RESID_T(WS_H, WS_WFO + (size_t)hl * SZ_WFO, DFF / 2, layer * NCOND * NMOD + (j ? 8 : 2), 0.5f / WFO_SCALE, base + 2, hl == 0 && rep == 0, true)
#else
        RP(3, base + 2) GEMM_RESID(WS_H, WS_WFO + (size_t)hl * SZ_WFO, DFF, layer * NCOND * NMOD + (j ? 8 : 2), 0.5f, base + 2, hl == 0 && rep == 0)
#endif
        if (j) continue;
        const int kind = layer % 3, slot = layer / 3, g5 = layer * NCOND * NMOD + 5;
        if (kind == 0) {
            RP(4, base + 3) { phase_norm(F, layer, 1, false); }
            RP(5, base + 4) { pg8::Gemm g{XN, WSP(bf16, WS_WQKV + (size_t)slot * SZ_WQKV), M, QKVD, D}; GEMM_SPLIT(EpiBf16, MapSimple, (MapSimple{NM, QKVD / 256, 0}), D / 64, (EpiBf16{WSP(bf16, WS_QKV), QKVD}), base + 4, 5) }
            RP(6, base + 5) { phase_qknorm(F, slot); }
            RP(7, base + 6) { phase_attn(F, slot); }
            RP(8, base + 7) GEMM_RESID(WS_OB, WS_WAO + (size_t)slot * SZ_WDD, D, g5, 1.0f, base + 7, false)
        } else if (kind == 1) {
            RP(9, base + 3) { phase_norm(F, layer, 1, false); }
            RP(10, base + 4) { pg8::Gemm g{XN, WSP(bf16, WS_WMI), M, MING, D}; GEMM_SPLIT(EpiMlstmIn, MapSimple, (MapSimple{NM, MING / 256, 0}), D / 64, (EpiMlstmIn{WSP(bf16, WS_MPROJ), WSP(float, WS_GATES), F.inp(I_MBG)}), base + 4, 10) }
            RP(11, base + 5) { phase_mlstm_scan(F); }
            RP(12, base + 6) { phase_mlstm_combine(F); }
            RP(13, base + 7) GEMM_RESID(WS_OB, WS_WMO, D, g5, 1.0f, base + 7, false)
        } else {
            RP(14, base + 3) { phase_norm_rwkv(F, layer); }
            RP(15, base + 4) { pg8::Gemm g{XN, WSP(bf16, WS_WRK), 6 * M, 3 * D + 768, D}; GEMM_SPLIT(EpiRwkv1, MapRwkv1, (MapRwkv1{}), D / 64, (EpiRwkv1{WSP(bf16, WS_RKV), WSP(bf16, WS_LAB)}), base + 4, 15) }
            RP(16, base + 5) { int k2 = 256; OPAQUE_S(k2); pg8::Gemm g{WSP(bf16, WS_LAB), WSP(bf16, WS_WLB), 3 * M, 5 * D, k2}; GEMM_SPLIT(EpiRwkv2, MapRwkv2, (MapRwkv2{}), k2 / 64, (EpiRwkv2{WSP(float, WS_DEC), WSP(bf16, WS_AG), F.inp(I_RW0), F.inp(I_RA0)}), base + 5, 16) }
            RP(17, base + 6) { phase_rwkv_scan(F); }
            RP(18, base + 7) { phase_rwkv_combine(F); }
            RP(19, base + 8) GEMM_RESID(WS_OB, WS_WRO, D, g5, 1.0f, base + 8, false)
        }
    }
#undef PH
}

#ifndef MK_PER_PHASE
#define MK_PER_PHASE 0
#endif
extern "C" void kernel_launch(void* const* d_in, const int* in_sizes, int n_in, void* d_out, int out_size, void* d_ws, size_t ws_size, hipStream_t stream) {
    static int grid = 0;
    if (grid == 0) {
        if (n_in != N_IN || (size_t)out_size != O_END || ws_size < WS_END) { fprintf(stderr, "kernel_launch: unexpected sizes: n_in %d out %d ws %zu (need %zu)\n", n_in, out_size, ws_size, (size_t)WS_END); grid = -1; return; }
#ifndef HIPEMU
        int dev = 0, cus = 0, per_cu = 0;
        if (hipGetDevice(&dev) != hipSuccess || hipDeviceGetAttribute(&cus, hipDeviceAttributeMultiprocessorCount, dev) != hipSuccess) { grid = -1; return; }
        if (hipFuncSetAttribute((const void*)hybrid_fwd, hipFuncAttributeMaxDynamicSharedMemorySize, LDS_BYTES) != hipSuccess) { fprintf(stderr, "kernel_launch: hipFuncSetAttribute failed\n"); grid = -1; return; }
        if (hipOccupancyMaxActiveBlocksPerMultiprocessor(&per_cu, (const void*)hybrid_fwd, NTHR, LDS_BYTES) != hipSuccess || per_cu < 1) fprintf(stderr, "kernel_launch: occupancy query reports %d\n", per_cu);
        (void)hipGetLastError();
        grid = cus;
#else
        grid = EMU_GRID;
#endif
    }
    if (grid < 0) return;
    (void)hipMemsetAsync((char*)d_ws + WS_CTL, 0, CTL_ZERO_BYTES, stream);
    Args a{};
    for (int i = 0; i < N_IN; ++i) a.in[i] = (const float*)d_in[i];
    a.out = (float*)d_out; a.ws = (unsigned char*)d_ws;
#if MK_PER_PHASE
    for (int p = 0; p < NPH; ++p) { a.ph_lo = p; a.ph_hi = p + 1; hipLaunchKernelGGL(hybrid_fwd, dim3(grid), dim3(NTHR), LDS_BYTES, stream, a);
#ifdef HIPEMU
        emu_after_phase(p, (float*)d_out);
#endif
    }
#else
    a.ph_lo = 0; a.ph_hi = NPH;
    hipLaunchKernelGGL(hybrid_fwd, dim3(grid), dim3(NTHR), LDS_BYTES, stream, a);
#endif
}
```

```cpp
#ifndef HIPEMU
#include <hip/hip_runtime.h>
#endif
#include <cstdio>

#define DI __device__ __forceinline__
#ifdef HIPEMU
#define LAS
#define GAS
DI unsigned __float_as_uint(float f) { unsigned u; memcpy(&u, &f, 4); return u; }
DI float __uint_as_float(unsigned u) { float f; memcpy(&f, &u, 4); return f; }
#define NT_LD(p) (*(p))
#define NT_ST(p, v) (*(p) = (v))
#define WSYNC() do { emu::wave_bar(); } while (0)
#define VM_WAIT() do { } while (0)
#define SCHED_FENCE() do { } while (0)
#define CFENCE() do { } while (0)
#else
#define LAS __attribute__((address_space(3)))
#define GAS __attribute__((address_space(1)))
#define NT_LD(p) __builtin_nontemporal_load(p)
#define NT_ST(p, v) __builtin_nontemporal_store((v), (p))
#define WSYNC() do { asm volatile("s_waitcnt lgkmcnt(0)" ::: "memory"); __builtin_amdgcn_wave_barrier(); } while (0)
#define VM_WAIT() asm volatile("s_waitcnt vmcnt(0)" ::: "memory")
#define SCHED_FENCE() __builtin_amdgcn_sched_barrier(0)
#define CFENCE() asm volatile("" ::: "memory")
#endif

#ifdef CFG_SMALL
constexpr int D = 512, BC = 2, TC = 128, BL = 2, TL = 256, PAST = 128, DFF = 512, AH = 4, AKV = 1, MH = 2;
#else
constexpr int D = 2048, BC = 32, TC = 256, BL = 4, TL = 1024, PAST = 256, DFF = 5632, AH = 16, AKV = 4, MH = 8;
#endif
constexpr int DEPTH = 4, NMOD = 9, GRIDW = 64, HD = 128, AG = AH / AKV, QKVD = (AH + 2 * AKV) * HD, NSLOT_ATTN = 2;
constexpr int MDV = D / MH, MDK = MDV / 2, MIN = 2 * MH * MDK + 2 * D, MING = MIN + 256, NGATE = 4 * MH;
constexpr int RH = D / 64, LW = 96, LA = 96, LG = 256;
constexpr int MC = BC * TC, ML = BL * TL, M = MC + ML, NM = M / 256, NCOND = 1 + BL;
constexpr float EPS = 1e-6f, GN_EPS = 64e-5f;
static_assert(D / AH == HD && MDV == 256 && MDK == 128 && MC % 256 == 0 && TL % 256 == 0 && DFF % 128 == 0 && D % 256 == 0 && PAST % 64 == 0 && TC % 64 == 0, "shape assumptions");

enum { I_XP = 0, I_XS, I_CK, I_CV, I_MC, I_MN, I_MM, I_RS, I_C, I_CCTX, I_MODW, I_MODB, I_NORMG, I_FWI, I_FWO, I_AQKV, I_AQN, I_AKN, I_ASINK, I_AWO,
       I_MWI, I_MWG, I_MBG, I_MON, I_MWO, I_RMU, I_RWRKV, I_RW0, I_RWA, I_RWB, I_RA0, I_RAA, I_RAB, I_RGA, I_RGB, I_RKK, I_RKA, I_RRK, I_RLNG, I_RLNB, I_RWO, N_IN };
constexpr size_t O_Y = 0, O_CK = (size_t)M * D, CKN = (size_t)BC * NSLOT_ATTN * TC * AKV * HD, O_CV = O_CK + CKN, O_MC = O_CV + CKN,
                 O_MN = O_MC + (size_t)BC * 2 * MH * MDK * MDV, O_MM = O_MN + (size_t)BC * 2 * MH * MDK, O_RS = O_MM + (size_t)BC * 2 * MH, O_END = O_RS + (size_t)BC * 2 * RH * 64 * 64;

constexpr size_t al256(size_t x) { return (x + 255) & ~(size_t)255; }
constexpr size_t WS_CTL = 0, CTL_ZERO_BYTES = 1u << 20;
constexpr size_t WS_MOD = CTL_ZERO_BYTES, WS_ROPE = WS_MOD + al256((size_t)DEPTH * NCOND * NMOD * D * 4);
constexpr size_t WS_WFI = WS_ROPE + al256(64 * 32 * 2 * 4), SZ_WFI = (size_t)2 * DFF * D * 2;
constexpr size_t WS_WFO = WS_WFI + 8 * SZ_WFI, SZ_WFO = (size_t)D * DFF * 2;
constexpr size_t WS_WQKV = WS_WFO + 8 * SZ_WFO, SZ_WQKV = (size_t)QKVD * D * 2;
constexpr size_t WS_WAO = WS_WQKV + 2 * SZ_WQKV, SZ_WDD = (size_t)D * D * 2;
constexpr size_t WS_WMI = WS_WAO + 2 * SZ_WDD;
constexpr size_t WS_WMO = WS_WMI + (size_t)MING * D * 2;
constexpr size_t WS_WRK = WS_WMO + SZ_WDD;
constexpr size_t WS_WLB = WS_WRK + (size_t)(3 * D + 768) * D * 2;
constexpr size_t WS_WRO = WS_WLB + (size_t)5 * D * 256 * 2;
constexpr size_t WS_XN = WS_WRO + SZ_WDD;
constexpr size_t WS_H = WS_XN + (size_t)6 * M * D * 2;
constexpr size_t WS_QKV = WS_H + al256((size_t)M * DFF * 2);
constexpr size_t WS_KB = WS_QKV + (size_t)M * QKVD * 2, WS_VB = WS_KB + (size_t)M * AKV * HD * 2;
constexpr size_t WS_OB = WS_VB + (size_t)M * AKV * HD * 2;
constexpr size_t WS_MPROJ = WS_OB + (size_t)M * D * 2;
constexpr size_t WS_GATES = WS_MPROJ + (size_t)M * MIN * 2;
constexpr size_t WS_HDIR = WS_GATES + al256((size_t)M * NGATE * 4);
constexpr size_t WS_RKV = WS_HDIR + (size_t)2 * M * D * 2;
constexpr size_t WS_LAB = WS_RKV + (size_t)3 * M * D * 2;
constexpr size_t WS_DEC = WS_LAB + (size_t)3 * M * 256 * 2;
constexpr size_t WS_AG = WS_DEC + (size_t)2 * M * D * 4;
constexpr size_t WS_YDIR = WS_AG + (size_t)3 * M * D * 2;
constexpr size_t WS_SLAB = WS_YDIR + (size_t)2 * M * D * 2;
constexpr size_t WS_END = WS_SLAB + (size_t)768 * 262144;
constexpr int CW_BAR = 4096;

constexpr int RING_BYTES = 131072, LDSCTL_OFF = RING_BYTES, MISC_OFF = LDSCTL_OFF + 320, LDS_BYTES = 147456;
constexpr int NWAVES = 8, NTHR = 512;

typedef unsigned short bf16;
typedef float f32x4 __attribute__((ext_vector_type(4)));
typedef float f32x2 __attribute__((ext_vector_type(2)));
typedef short bf16x8 __attribute__((ext_vector_type(8)));
typedef short s16x4 __attribute__((ext_vector_type(4)));
typedef unsigned u32x4 __attribute__((ext_vector_type(4)));
typedef unsigned u32x2 __attribute__((ext_vector_type(2)));

#ifdef HIPEMU
DI unsigned f2bf(float f) { unsigned u = __float_as_uint(f); return (u + 0x7fffu + ((u >> 16) & 1u)) >> 16; }
DI unsigned pk2(float lo, float hi) { return f2bf(lo) | (f2bf(hi) << 16); }
DI float fast_rcp(float x) { return 1.0f / x; }
#else
DI unsigned pk2(float lo, float hi) { unsigned r; asm("v_cvt_pk_bf16_f32 %0, %1, %2" : "=v"(r) : "v"(lo), "v"(hi)); return r; }
DI unsigned f2bf(float f) { return pk2(f, 0.f) & 0xffffu; }
DI float fast_rcp(float x) { return __builtin_amdgcn_rcpf(x); }
#endif
#ifndef FFN_OUT_FP8
#define FFN_OUT_FP8 1
#endif
#ifndef FFN_IN_FP8_FROM
#define FFN_IN_FP8_FROM 3
#endif
constexpr float WFI_SCALE = 32.0f;
constexpr float WFO_SCALE = 64.0f;
#ifdef HIPEMU
DI unsigned f2e4m3(float f) { const unsigned s = f < 0.f ? 0x80u : 0u; float a = fabsf(f); if (!(a == a)) return 0x7fu; if (a > 448.f) a = 448.f; if (a < 0.0009765625f) return s;
    int e; frexpf(a, &e); e -= 1; if (e < -6) e = -6; const float step = ldexpf(1.0f, e - 3); float q = rintf(a / step);
    float v = q * step; if (v > 448.f) v = 448.f; if (v == 0.f) return s; int e2; frexpf(v, &e2); e2 -= 1; if (e2 < -6) { return s | (unsigned)(v / ldexpf(1.0f, -9)); }
    const unsigned m = (unsigned)(v / ldexpf(1.0f, e2 - 3)) - 8u; return s | ((unsigned)(e2 + 7) << 3) | m; }
DI float e4m32f(unsigned b) { const float s = (b & 0x80u) ? -1.f : 1.f; const int e = (b >> 3) & 15, m = b & 7; return e == 0 ? s * ldexpf((float)m, -9) : s * ldexpf((float)(8 + m), e - 10); }
DI unsigned pk4_fp8(float a, float b, float c, float d) { return f2e4m3(a) | (f2e4m3(b) << 8) | (f2e4m3(c) << 16) | (f2e4m3(d) << 24); }
#else
DI unsigned pk4_fp8(float a, float b, float c, float d) { int v = __builtin_amdgcn_cvt_pk_fp8_f32(a, b, 0, false); v = __builtin_amdgcn_cvt_pk_fp8_f32(c, d, v, true); return (unsigned)v; }
#endif
#ifdef HIPEMU
DI float fast_exp2(float x) { return exp2f(x); }
#else
DI float fast_exp2(float x) { return __builtin_amdgcn_exp2f(x); }
#endif
DI float bf2f(unsigned b) { return __uint_as_float(b << 16); }
DI float bflo(unsigned w) { return __uint_as_float(w << 16); }
DI float bfhi(unsigned w) { return __uint_as_float(w & 0xffff0000u); }
DI float wave_sum(float v) {
#ifdef HIPEMU
#pragma unroll
    for (int o = 1; o < 64; o <<= 1) v += __shfl_xor(v, o);
    return v;
#else
#define DPP_ADD(ctrl) v += __builtin_bit_cast(float, __builtin_amdgcn_update_dpp(0, __builtin_bit_cast(int, v), ctrl, 0xF, 0xF, true))
    DPP_ADD(0xB1); DPP_ADD(0x4E); DPP_ADD(0x141); DPP_ADD(0x140);
#undef DPP_ADD
    const int iv = __builtin_bit_cast(int, v);
    const float r0 = __builtin_bit_cast(float, __builtin_amdgcn_readlane(iv, 0)), r1 = __builtin_bit_cast(float, __builtin_amdgcn_readlane(iv, 16));
    const float r2 = __builtin_bit_cast(float, __builtin_amdgcn_readlane(iv, 32)), r3 = __builtin_bit_cast(float, __builtin_amdgcn_readlane(iv, 48));
    return (r0 + r1) + (r2 + r3);
#endif
}
DI float wave_max(float v) {
#pragma unroll
    for (int o = 1; o < 64; o <<= 1) v = fmaxf(v, __shfl_xor(v, o));
    return v;
}
DI float sigmoidf_(float x) { return fast_rcp(1.0f + __expf(-x)); }
DI float siluf_(float x) { return x * fast_rcp(1.0f + __expf(-x)); }
DI int cond_of_row(int row) { return row < MC ? 0 : 1 + (row - MC) / TL; }

DI int opq(int x) {
#ifndef HIPEMU
    asm volatile("" : "+s"(x));
#endif
    return x; }
#ifndef HIPEMU
namespace pg8 {
#define PG8_LAS __attribute__((address_space(3)))
typedef unsigned short bf16_t;
typedef short bf16x8 __attribute__((ext_vector_type(8)));
typedef float f32x4 __attribute__((ext_vector_type(4)));
typedef unsigned u32x4 __attribute__((ext_vector_type(4)));
typedef int i32x4 __attribute__((ext_vector_type(4)));
constexpr int BM = 256, BK = 64, HALF = 128, HTB = HALF * BK * 2  , STAGE_BYTES = 8 * HTB, NXCD = 8, WGM = 8;

__host__ __device__ __forceinline__ int lds_byte(int r, int c) { const int st = (r >> 4) * 2 + (c >> 5), rr = r & 15, cc = c & 31, ob = rr * 64 + cc * 2; return st * 1024 + (ob ^ (((ob >> 9) & 1) << 5)); }
__host__ __device__ __forceinline__ void stage_rc(int b, int& R, int& C) { const int st = b / 1024, sb = b % 1024, swz = sb ^ (((sb >> 9) & 1) << 5); R = (st >> 1) * 16 + swz / 64; C = (st & 1) * 32 + (swz % 64) / 2; }
__host__ __device__ __forceinline__ int perm32(int rho) { const int n = rho >> 4, i = rho & 15; return 8 * (i >> 2) + 4 * n + (i & 3); }

struct Unit { int pm, pn, k0, nt, role, slot, half; };
struct Gemm { const bf16_t* A; const bf16_t* Bt; int M, N, K; };

template <class Epi, class Sched, bool ALIGN_EPI = false, bool SP2 = false, bool FP8 = false>
__device__ __forceinline__ void gemm_phase(PG8_LAS unsigned char* lds, const Gemm g, const Sched& S, const Epi& E) {
    int tid_ = threadIdx.x; asm volatile("" : "+v"(tid_));
    const int tid = tid_, wid = __builtin_amdgcn_readfirstlane(tid >> 6), lane = tid & 63, wr = wid >> 2, wc = wid & 3, fr = lane & 15, fq = lane >> 4;
    const int K = g.K;
    unsigned voffA[2], voffB[2];
#pragma unroll
    for (int i = 0; i < 2; ++i) { int R, C; stage_rc(tid * 16 + i * 8192, R, C); const int Rb = Epi::PERM ? ((R & ~31) + perm32(R & 31)) : R;
        voffA[i] = (unsigned)(R * K + C) * 2u; voffB[i] = (unsigned)(Rb * K + C) * 2u; }
    const size_t kstep = (size_t)(BK * 2);
    const size_t hstep = (size_t)HALF * K * 2;
    const size_t tstep = 2 * hstep;
    const unsigned ldsw = (unsigned)wid * 1024u;
    const int aoff = lds_byte(wr * 64 + fr, fq * 8), boff = lds_byte(wc * 32 + fr, fq * 8);
#define PG8_SA(b, h) (((b) * 2 + (h)) * HTB)
#define PG8_SB(b, h) ((4 + (b) * 2 + (h)) * HTB)
#define PG8_STAGE(bufoff, gbase, voff) do { _Pragma("unroll") for (int _i = 0; _i < 2; ++_i) \
        __builtin_amdgcn_global_load_lds((const unsigned*)((const char*)(gbase) + (voff)[_i]), (PG8_LAS unsigned*)(lds + (bufoff) + ldsw + _i * 8192), 16, 0, 0); } while (0)
#define PG8_LDA(dst, b, h) do { _Pragma("unroll") for (int m = 0; m < 4; ++m) _Pragma("unroll") for (int k = 0; k < 2; ++k) dst[m][k] = *(const PG8_LAS bf16x8*)(lds + PG8_SA(b, h) + aoff + m * 2048 + k * 1024); } while (0)
#define PG8_LDB(dst, b, h) do { _Pragma("unroll") for (int n = 0; n < 2; ++n) _Pragma("unroll") for (int k = 0; k < 2; ++k) dst[n][k] = *(const PG8_LAS bf16x8*)(lds + PG8_SB(b, h) + boff + n * 2048 + k * 1024); } while (0)
#define PG8_CAT8(x) __builtin_shufflevector(__builtin_bit_cast(i32x4, x[0]), __builtin_bit_cast(i32x4, x[1]), 0, 1, 2, 3, 4, 5, 6, 7)
#define PG8_MMA(ai, bj, At, Bt) do { __builtin_amdgcn_s_setprio(1); _Pragma("unroll") for (int m = 0; m < 4; ++m) _Pragma("unroll") for (int n = 0; n < 2; ++n) { \
        if constexpr (FP8) acc[ai][bj][m][n] = __builtin_amdgcn_mfma_scale_f32_16x16x128_f8f6f4(PG8_CAT8(Bt[n]), PG8_CAT8(At[m]), acc[ai][bj][m][n], 0, 0, 0, 0, 0, 0); \
        else { _Pragma("unroll") for (int k = 0; k < 2; ++k) acc[ai][bj][m][n] = __builtin_amdgcn_mfma_f32_16x16x32_bf16(Bt[n][k], At[m][k], acc[ai][bj][m][n], 0, 0, 0); } } __builtin_amdgcn_s_setprio(0); } while (0)
#define PG8_WAIT_V(n) asm volatile("s_waitcnt vmcnt(" #n ")" ::: "memory")
#define PG8_WAIT_L(n) asm volatile("s_waitcnt lgkmcnt(" #n ")" ::: "memory")
#define PG8_BAR __builtin_amdgcn_s_barrier()
#define PG8_SCHED __builtin_amdgcn_sched_barrier(0)
    Unit cur, nxt; int ui = 0;
    if (!S.next(0, cur)) return;
    f32x4 acc[2][2][4][2];
    E.init_acc(acc, cur);
    bf16x8 At[4][2], B0[2][2], B1[2][2];
    const char* cA = (const char*)g.A + (size_t)cur.pm * tstep + (size_t)cur.k0 * kstep + (cur.half == 2 ? hstep : 0); const char* cB = (const char*)g.Bt + (size_t)cur.pn * tstep + (size_t)cur.k0 * kstep;
    S.a_ready(cur);
    if constexpr (SP2) {
        PG8_STAGE(PG8_SB(0, 0), cB, voffB); PG8_STAGE(PG8_SB(0, 1), cB + hstep, voffB); PG8_STAGE(PG8_SA(0, 0), cA, voffA); PG8_STAGE(PG8_SA(0, 1), cA + hstep, voffA);
        if (wr == 1) PG8_BAR;
        PG8_WAIT_V(2); PG8_BAR;
        PG8_STAGE(PG8_SB(1, 0), cB + kstep, voffB); PG8_STAGE(PG8_SA(1, 0), cA + kstep, voffA); PG8_STAGE(PG8_SB(1, 1), cB + hstep + kstep, voffB);
        PG8_WAIT_V(6); PG8_BAR;
    } else {
        PG8_STAGE(PG8_SB(0, 0), cB, voffB); PG8_STAGE(PG8_SA(0, 0), cA, voffA); PG8_STAGE(PG8_SB(0, 1), cB + hstep, voffB); PG8_STAGE(PG8_SA(0, 1), cA + hstep, voffA);
        if (wr == 1) PG8_BAR;
        PG8_WAIT_V(4); PG8_BAR;
        PG8_STAGE(PG8_SB(1, 0), cB + kstep, voffB); PG8_STAGE(PG8_SA(1, 0), cA + kstep, voffA); PG8_STAGE(PG8_SB(1, 1), cB + hstep + kstep, voffB);
        PG8_WAIT_V(6); PG8_BAR;
    }
    for (;;) {
        const bool has_next = S.next(ui + 1, nxt);
        const char* nA = has_next ? (const char*)g.A + (size_t)nxt.pm * tstep + (size_t)nxt.k0 * kstep + (nxt.half == 2 ? hstep : 0) : cA; const char* nB = has_next ? (const char*)g.Bt + (size_t)nxt.pn * tstep + (size_t)nxt.k0 * kstep : cB;
        const int nt = cur.nt; const bool full = cur.half == 0;
        for (int t = 0; t < nt; t += 2) {
            const bool last = (t == nt - 2);
            const char* a1 = cA + (size_t)(t + 1) * kstep;
            const char* a2 = last ? nA : cA + (size_t)(t + 2) * kstep; const char* b2 = last ? nB : cB + (size_t)(t + 2) * kstep;
            const char* a3 = a2 + kstep; const char* b3 = b2 + kstep;
            if (last && has_next) S.a_ready(nxt);
            if constexpr (SP2) {
            PG8_LDB(B0, 0, 0); PG8_LDB(B1, 0, 1); PG8_SCHED; PG8_LDA(At, 0, 0); PG8_STAGE(PG8_SA(1, 1), a1 + hstep, voffA);
            PG8_WAIT_V(8); PG8_WAIT_L(0); PG8_BAR; PG8_MMA(0, 0, At, B0); PG8_MMA(0, 1, At, B1); PG8_BAR; PG8_SCHED;
            PG8_LDA(At, 0, 1); PG8_STAGE(PG8_SB(0, 0), b2, voffB); PG8_STAGE(PG8_SB(0, 1), b2 + hstep, voffB); PG8_STAGE(PG8_SA(0, 0), a2, voffA);
            PG8_WAIT_V(8); PG8_WAIT_L(0); PG8_BAR; if (full) { PG8_MMA(1, 0, At, B0); PG8_MMA(1, 1, At, B1); } PG8_BAR; PG8_SCHED;
            PG8_LDB(B0, 1, 0); PG8_LDB(B1, 1, 1); PG8_SCHED; PG8_LDA(At, 1, 0); PG8_STAGE(PG8_SA(0, 1), a2 + hstep, voffA);
            PG8_WAIT_V(8); PG8_WAIT_L(0); PG8_BAR; PG8_MMA(0, 0, At, B0); PG8_MMA(0, 1, At, B1); PG8_BAR; PG8_SCHED;
            PG8_LDA(At, 1, 1); PG8_STAGE(PG8_SB(1, 0), b3, voffB); PG8_STAGE(PG8_SB(1, 1), b3 + hstep, voffB); PG8_STAGE(PG8_SA(1, 0), a3, voffA);
            PG8_WAIT_V(8); PG8_WAIT_L(0); PG8_BAR; if (full) { PG8_MMA(1, 0, At, B0); PG8_MMA(1, 1, At, B1); } PG8_BAR; PG8_SCHED;
            } else {
            PG8_LDB(B0, 0, 0); PG8_SCHED; PG8_LDA(At, 0, 0); PG8_STAGE(PG8_SA(1, 1), a1 + hstep, voffA);
            PG8_WAIT_L(8); PG8_BAR; PG8_WAIT_L(0); PG8_MMA(0, 0, At, B0); PG8_BAR; PG8_SCHED;
            PG8_LDB(B1, 0, 1); PG8_STAGE(PG8_SB(0, 0), b2, voffB);
            PG8_BAR; PG8_WAIT_L(0); PG8_MMA(0, 1, At, B1); PG8_BAR;
            PG8_LDA(At, 0, 1); PG8_STAGE(PG8_SA(0, 0), a2, voffA);
            PG8_BAR; PG8_WAIT_L(0); PG8_MMA(1, 0, At, B0); PG8_BAR; PG8_SCHED;
            PG8_STAGE(PG8_SB(0, 1), b2 + hstep, voffB);
            PG8_WAIT_V(6); PG8_BAR; PG8_MMA(1, 1, At, B1); PG8_BAR;
            PG8_LDB(B0, 1, 0); PG8_SCHED; PG8_LDA(At, 1, 0); PG8_STAGE(PG8_SA(0, 1), a2 + hstep, voffA);
            PG8_WAIT_L(8); PG8_BAR; PG8_WAIT_L(0); PG8_MMA(0, 0, At, B0); PG8_BAR; PG8_SCHED;
            PG8_LDB(B1, 1, 1); PG8_STAGE(PG8_SB(1, 0), b3, voffB);
            PG8_BAR; PG8_WAIT_L(0); PG8_MMA(0, 1, At, B1); PG8_BAR;
            PG8_LDA(At, 1, 1); PG8_STAGE(PG8_SA(1, 0), a3, voffA);
            PG8_BAR; PG8_WAIT_L(0); PG8_MMA(1, 0, At, B0); PG8_BAR; PG8_SCHED;
            PG8_STAGE(PG8_SB(1, 1), b3 + hstep, voffB);
            PG8_WAIT_V(6); PG8_BAR; PG8_MMA(1, 1, At, B1); PG8_BAR;
            }
        }
        if constexpr (ALIGN_EPI) { if (wr == 0) PG8_BAR; }
        if constexpr (!Epi::AFTER_DRAIN) { E(acc, cur, wr, wc, fr, fq); S.done(cur); }
        if (!has_next) break;
        E.init_acc(acc, nxt);
        cur = nxt; cA = nA; cB = nB; ++ui;
        if constexpr (ALIGN_EPI) { if (wr == 1) PG8_BAR; }
    }
    PG8_WAIT_V(0);
    if constexpr (!ALIGN_EPI) { if (wr == 0) PG8_BAR; }
    PG8_BAR;
    if constexpr (Epi::AFTER_DRAIN) { E.fused(acc, cur, wr, wc, fr, fq, lds, wid, lane); S.done(cur); }
#undef PG8_SA
#undef PG8_SB
#undef PG8_STAGE
#undef PG8_LDA
#undef PG8_LDB
#undef PG8_MMA
#undef PG8_CAT8
#undef PG8_WAIT_V
#undef PG8_WAIT_L
#undef PG8_BAR
#undef PG8_SCHED
}
}
#else
namespace pg8 {
#define PG8_LAS
typedef unsigned short bf16_t;
typedef short bf16x8 __attribute__((ext_vector_type(8)));
typedef float f32x4 __attribute__((ext_vector_type(4)));
typedef unsigned u32x4 __attribute__((ext_vector_type(4)));
constexpr int BM = 256, BK = 64, HALF = 128, STAGE_BYTES = 131072;
struct Unit { int pm, pn, k0, nt, role, slot, half; };
struct Gemm { const bf16_t* A; const bf16_t* Bt; int M, N, K; };
extern float* emu_tile;
template <class Epi, class Sched, bool ALIGN_EPI = false, bool SP2 = false, bool FP8 = false>
inline void gemm_phase(unsigned char* lds, const Gemm g, const Sched& S, const Epi& E) {
    const int tid = threadIdx.x, wid = tid >> 6, lane = tid & 63, wr = wid >> 2, wc = wid & 3, fr = lane & 15, fq = lane >> 4;
    Unit u; float* tile = emu_tile + (size_t)blockIdx.x * 65536;
    for (int i = 0; S.next(i, u); ++i) {
        __syncthreads();
        if (tid == 0) {
            for (int r = 0; r < 256; ++r) for (int c = 0; c < 256; ++c) {
                if (u.half && r >= 128) { tile[r * 256 + c] = 0.f; continue; }
                const bf16_t* a = g.A + ((size_t)u.pm * 256 + r + (u.half == 2 ? 128 : 0)) * g.K; const bf16_t* b = g.Bt + ((size_t)u.pn * 256 + c) * g.K; float s = 0.f;
                if (FP8) { const unsigned char* a8 = (const unsigned char*)a; const unsigned char* b8 = (const unsigned char*)b; for (int k = u.k0 * 128; k < (u.k0 + u.nt) * 128; ++k) s += e4m32f(a8[k]) * e4m32f(b8[k]); }
                else
                for (int k = u.k0 * 64; k < (u.k0 + u.nt) * 64; ++k) { unsigned ua = (unsigned)a[k] << 16, ub = (unsigned)b[k] << 16; float fa, fb; memcpy(&fa, &ua, 4); memcpy(&fb, &ub, 4); s += fa * fb; }
                tile[r * 256 + c] = s; }
        }
        __syncthreads();
        f32x4 acc[2][2][4][2];
        E.init_acc(acc, u);
        for (int ai = 0; ai < 2; ++ai) for (int bj = 0; bj < 2; ++bj) for (int m = 0; m < 4; ++m) for (int n = 0; n < 2; ++n) for (int j = 0; j < 4; ++j) {
            const int r = 128 * ai + 64 * wr + 16 * m + fr, c = Epi::PERM ? 128 * bj + 32 * wc + 8 * fq + 4 * n + j : 128 * bj + 32 * wc + 16 * n + 4 * fq + j;
            acc[ai][bj][m][n][j] += tile[r * 256 + c]; }
        E(acc, u, wr, wc, fr, fq);
    }
    __syncthreads();
}
}
#endif

DI void map_unit(int L, int nM, int nN, int& pm, int& pn) {
    const int nwg = nM * nN; int wgid = L;
    { const int q = nwg / 8, r = nwg % 8, xcd = wgid % 8, off = wgid / 8; wgid = (xcd < r ? xcd * (q + 1) : r * (q + 1) + (xcd - r) * q) + off; }
    const int nig = 8 * nN, gid = wgid / nig, fm = gid * 8, gsz = (nM - fm) < 8 ? (nM - fm) : 8;
    pm = fm + ((wgid % nig) % gsz); pn = (wgid % nig) / gsz;
}
struct MapSimple { int nM, nN, same; DI int total() const { return nM * nN; } DI void operator()(int L, int& pm, int& pn) const { map_unit(L, nM, nN, pm, pn); if (same) { pm = 0; pn = 0; } } };
struct MapRwkv1 {
    DI int total() const { return 3 * NM * (D / 256) + 3 * NM; }
    DI void operator()(int L, int& pm, int& pn) const { const int nN = D / 256, big = NM * nN;
        if (L < 3 * big) { const int p = L / big; int a, b; map_unit(L % big, NM, nN, a, b); pm = p * NM + a; pn = p * nN + b; }
        else { L -= 3 * big; const int p = L / NM; pm = (3 + p) * NM + L % NM; pn = 3 * nN + p; } }
};
struct MapRwkv2 {
    DI int total() const { return 5 * NM * (D / 256); }
    DI void operator()(int L, int& pm, int& pn) const { const int nN = D / 256, big = NM * nN; const int j = L / big; int a, b; map_unit(L % big, NM, nN, a, b);
        const int aidx = j < 2 ? 0 : (j < 4 ? 1 : 2); pm = aidx * NM + a; pn = j * nN + b; }
};
#ifndef KSPLIT_SKEW
#define KSPLIT_SKEW 2
#endif
template <class Map> struct OrderSplit {
    Map map; int ntK, G_, c_, allow4;
#ifndef HALF_TAIL
#define HALF_TAIL 1
#endif
#ifndef SPLIT_MODE
#define SPLIT_MODE 0
#endif
    DI int choose_P(int rem, int G) const { if (rem == 0 || SPLIT_MODE == 0) return 1; if (!(SPLIT_MODE == 2 || allow4) && 2 * rem != G) return 1;
        if (ntK >= 16 && ntK % 8 == 0 && 2 * rem != G) return 4; if (ntK >= 8 && ntK % 4 == 0) return 2; return 1; }
    DI bool next(int i, pg8::Unit& u) const {
        const int G = opq(G_), c = opq(c_);
        const int U = map.total(), R = U / G, rem = U - R * G, P = choose_P(rem, G);
        u.k0 = 0; u.nt = ntK; u.role = 0; u.slot = 0; u.half = 0;
        if (P == 1) {
            if (HALF_TAIL && rem > 0 && 2 * rem <= G) {
                if (i < R) { map(i * G + c, u.pm, u.pn); return true; }
                if (i > R || c >= 2 * rem) return false;
                map(R * G + c % rem, u.pm, u.pn); u.half = 1 + c / rem; return true; }
            const long L = (long)i * G + c; if (L >= U) return false; map((int)L, u.pm, u.pn); return true; }
        const int nprod = rem * (P - 1), ntp = ntK / P + (P == 2 && ntK >= 16 ? KSPLIT_SKEW : 0);
        const int np = c < nprod ? (nprod - 1 - c) / G + 1 : 0;
        if (i < np) { const int idx = c + i * G, su = idx / (P - 1), j = idx % (P - 1); map(R * G + su, u.pm, u.pn); u.k0 = j * ntp; u.nt = ntp; u.role = 1; u.slot = idx; return true; }
        i -= np;
        if (i < R) { map(i * G + c, u.pm, u.pn); return true; }
        i -= R;
        const int su = G - 1 - c + i * G; if (i > 0 || su >= rem) return false;
        map(R * G + su, u.pm, u.pn); u.k0 = (P - 1) * ntp; u.nt = ntK - u.k0; u.role = 2; u.slot = su; return true;
    }
    DI int nprod_per_unit() const { const int U = map.total(), rem = U % G_; return choose_P(rem, G_) - 1; }
    DI void a_ready(const pg8::Unit&) const {}
    DI void done(const pg8::Unit&) const {}
};

typedef const pg8::f32x4 (&AccRef)[2][2][4][2];
template <bool S8> struct EpiSwigluT {
    static constexpr bool PERM = true, AFTER_DRAIN = false;
    bf16* H; int skip;
    DI void operator()(AccRef acc, const pg8::Unit& u, int wr, int wc, int fr, int fq) const {
        if (skip) return;
        const int row0 = u.pm * 256 + wr * 64 + fr + (u.half == 2 ? 128 : 0), col0 = u.pn * 128 + wc * 32 + 8 * fq;
#pragma unroll
        for (int ai = 0; ai < 2; ++ai) { if (ai == 1 && u.half) break;
#pragma unroll
            for (int m = 0; m < 4; ++m) {
                float h[8];
#pragma unroll
                for (int n = 0; n < 2; ++n)
#pragma unroll
                    for (int jp = 0; jp < 2; ++jp) { const f32x2 gt = (f32x2){acc[ai][0][m][n][2 * jp], acc[ai][0][m][n][2 * jp + 1]}, up = (f32x2){acc[ai][1][m][n][2 * jp], acc[ai][1][m][n][2 * jp + 1]};
                        constexpr float S2 = S8 ? WFI_SCALE * WFI_SCALE : 1.0f, AS = S8 ? -1.44269504f / WFI_SCALE : -1.44269504f;
                        const f32x2 ar = gt * AS; f32x2 e; e.x = fast_exp2(ar.x); e.y = fast_exp2(ar.y);
                        const f32x2 d = e * S2 + S2; f32x2 r; r.x = fast_rcp(d.x); r.y = fast_rcp(d.y);
                        const f32x2 hv = (gt * up) * r; h[4 * n + 2 * jp] = hv.x; h[4 * n + 2 * jp + 1] = hv.y; }
#if FFN_OUT_FP8
                u32x2 w; w.x = pk4_fp8(h[0], h[1], h[2], h[3]); w.y = pk4_fp8(h[4], h[5], h[6], h[7]);
                *(u32x2*)((unsigned char*)H + (size_t)(row0 + ai * 128 + m * 16) * DFF + col0) = w;
#else
                u32x4 w; w.x = pk2(h[0], h[1]); w.y = pk2(h[2], h[3]); w.z = pk2(h[4], h[5]); w.w = pk2(h[6], h[7]);
                *(u32x4*)(H + (size_t)(row0 + ai * 128 + m * 16) * DFF + col0) = w;
#endif
            } }
    }
};
typedef EpiSwigluT<false> EpiSwiglu; typedef EpiSwigluT<true> EpiSwiglu8;
struct EpiResid {
    static constexpr bool PERM = false, AFTER_DRAIN = false;
    float* X; const float* gate0;
    float gs; int skip;
    const float* xin_c; const float* xin_l;
    DI void operator()(AccRef acc, const pg8::Unit& u, int wr, int wc, int fr, int fq) const {
        if (skip) return;
        const int row0 = u.pm * 256 + wr * 64 + fr + (u.half == 2 ? 128 : 0), col0 = u.pn * 256 + wc * 32 + 4 * fq;
        const float* Xr = xin_c ? (u.pm * 256 < MC ? xin_c : xin_l - (size_t)MC * D) : X;
        const float* gp = gate0 + (size_t)cond_of_row(u.pm * 256) * NMOD * D + col0;
        f32x4 gv[2][2];
#pragma unroll
        for (int bj = 0; bj < 2; ++bj)
#pragma unroll
            for (int n = 0; n < 2; ++n) gv[bj][n] = *(const f32x4*)(gp + bj * 128 + n * 16) * gs;
#pragma unroll
        for (int ai = 0; ai < 2; ++ai) { if (ai == 1 && u.half) break;
#pragma unroll
            for (int mp = 0; mp < 2; ++mp) { const size_t o0 = (size_t)(row0 + ai * 128 + mp * 32) * D + col0;
                f32x4 xv[2][2][2];
#pragma unroll
                for (int m = 0; m < 2; ++m)
#pragma unroll
                    for (int bj = 0; bj < 2; ++bj)
#pragma unroll
                        for (int n = 0; n < 2; ++n) xv[m][bj][n] = *(const f32x4*)(Xr + o0 + (size_t)m * 16 * D + bj * 128 + n * 16);
#pragma unroll
                for (int m = 0; m < 2; ++m)
#pragma unroll
                    for (int bj = 0; bj < 2; ++bj)
#pragma unroll
                        for (int n = 0; n < 2; ++n) *(f32x4*)(X + o0 + (size_t)m * 16 * D + bj * 128 + n * 16) = xv[m][bj][n] + gv[bj][n] * acc[ai][bj][2 * mp + m][n]; } }
    }
};
struct EpiBf16 {
    static constexpr bool PERM = true, AFTER_DRAIN = false;
    bf16* O; int ldc;
    DI void operator()(AccRef acc, const pg8::Unit& u, int wr, int wc, int fr, int fq) const {
        const int row0 = u.pm * 256 + wr * 64 + fr + (u.half == 2 ? 128 : 0), col0 = u.pn * 256 + wc * 32 + 8 * fq;
#pragma unroll
        for (int ai = 0; ai < 2; ++ai) { if (ai == 1 && u.half) break;
#pragma unroll
            for (int m = 0; m < 4; ++m) { bf16* rowp = O + (size_t)(row0 + ai * 128 + m * 16) * ldc + col0;
#pragma unroll
                for (int bj = 0; bj < 2; ++bj) { const pg8::f32x4 v0 = acc[ai][bj][m][0], v1 = acc[ai][bj][m][1];
                    u32x4 w; w.x = pk2(v0[0], v0[1]); w.y = pk2(v0[2], v0[3]); w.z = pk2(v1[0], v1[1]); w.w = pk2(v1[2], v1[3]);
                    *(u32x4*)(rowp + bj * 128) = w; } } }
    }
};
struct EpiMlstmIn {
    static constexpr bool PERM = true, AFTER_DRAIN = false;
    bf16* P; float* Gt; const float* bg;
    DI void operator()(AccRef acc, const pg8::Unit& u, int wr, int wc, int fr, int fq) const {
        const int row0 = u.pm * 256 + wr * 64 + fr + (u.half == 2 ? 128 : 0);
        if (u.pn < MIN / 256) { EpiBf16 e{P, MIN}; e(acc, u, wr, wc, fr, fq); return; }
        if (wc != 0) return;
        f32x4 bv[2];
#pragma unroll
        for (int n = 0; n < 2; ++n) bv[n] = 8 * fq + 4 * n < NGATE ? *(const f32x4*)(bg + 8 * fq + 4 * n) : (f32x4){0.f, 0.f, 0.f, 0.f};
#pragma unroll
        for (int ai = 0; ai < 2; ++ai) { if (ai == 1 && u.half) break;
#pragma unroll
            for (int m = 0; m < 4; ++m)
#pragma unroll
                for (int n = 0; n < 2; ++n) if (8 * fq + 4 * n < NGATE) *(f32x4*)(Gt + (size_t)(row0 + ai * 128 + m * 16) * NGATE + 8 * fq + 4 * n) = acc[ai][0][m][n] + bv[n]; }
    }
};
struct EpiRwkv1 {
    static constexpr bool PERM = true, AFTER_DRAIN = false;
    bf16* RKV; bf16* LAB;
    DI void operator()(AccRef acc, const pg8::Unit& u, int wr, int wc, int fr, int fq) const {
        const int p = u.pm / NM, pm = u.pm % NM; const int row0 = pm * 256 + wr * 64 + fr + (u.half == 2 ? 128 : 0);
        const int q = p - 3; const int col0 = (p < 3 ? (u.pn - p * (D / 256)) * 256 : 0) + wc * 32 + 8 * fq, ld = p < 3 ? D : 256;
        bf16* base = p < 3 ? RKV + (size_t)p * M * D : LAB + (size_t)q * M * 256;
#pragma unroll
        for (int ai = 0; ai < 2; ++ai) { if (ai == 1 && u.half) break;
#pragma unroll
            for (int m = 0; m < 4; ++m) { bf16* rowp = base + (size_t)(row0 + ai * 128 + m * 16) * ld + col0;
#pragma unroll
                for (int bj = 0; bj < 2; ++bj) { float h[8];
#pragma unroll
                    for (int n = 0; n < 2; ++n)
#pragma unroll
                        for (int j = 0; j < 4; ++j) { const float x = acc[ai][bj][m][n][j]; h[4 * n + j] = q == 0 ? tanhf(x) : (q == 2 ? sigmoidf_(x) : x); }
                    u32x4 w; w.x = pk2(h[0], h[1]); w.y = pk2(h[2], h[3]); w.z = pk2(h[4], h[5]); w.w = pk2(h[6], h[7]);
                    *(u32x4*)(rowp + bj * 128) = w; } } }
    }
};
struct EpiRwkv2 {
    static constexpr bool PERM = false, AFTER_DRAIN = false;
    float* DEC; bf16* AG; const float* w0; const float* a0;
    DI void operator()(AccRef acc, const pg8::Unit& u, int wr, int wc, int fr, int fq) const {
        const int j = u.pn / (D / 256), pn = u.pn % (D / 256), pm = u.pm % NM;
        const int row0 = pm * 256 + wr * 64 + fr + (u.half == 2 ? 128 : 0), col0 = pn * 256 + wc * 32 + 4 * fq;
        const float* bsrc = j < 2 ? w0 + j * D : a0 + (j < 4 ? j - 2 : 0) * D;
        const int mode = j < 2 ? 0 : (j < 4 ? 1 : 2);
        f32x4 bnext = mode < 2 ? *(const f32x4*)(bsrc + col0) : (f32x4){0.f, 0.f, 0.f, 0.f};
#pragma unroll
        for (int bn = 0; bn < 4; ++bn) { const int bj = bn >> 1, n = bn & 1; const int c = col0 + bj * 128 + n * 16;
            const f32x4 bv = bnext; if (bn < 3 && mode < 2) bnext = *(const f32x4*)(bsrc + col0 + ((bn + 1) >> 1) * 128 + ((bn + 1) & 1) * 16);
#pragma unroll
            for (int ai = 0; ai < 2; ++ai) { if (ai == 1 && u.half) break;
#pragma unroll
                for (int m = 0; m < 4; ++m) { f32x4 v = acc[ai][bj][m][n] + bv; const size_t o = (size_t)(row0 + ai * 128 + m * 16) * D + c;
                    if (mode == 0) {
#pragma unroll
                        for (int e2 = 0; e2 < 4; ++e2) v[e2] = __expf(-0.60653066f * sigmoidf_(v[e2]));
                        *(f32x4*)(DEC + (size_t)j * M * D + o) = v; }
                    else { if (mode == 1) {
#pragma unroll
                            for (int e2 = 0; e2 < 4; ++e2) v[e2] = sigmoidf_(v[e2]); }
                        u32x2 w; w.x = pk2(v[0], v[1]); w.y = pk2(v[2], v[3]); *(u32x2*)(AG + (size_t)(j - 2) * M * D + o) = w; } } } }
    }
};

constexpr int SLAB_PARTS = 768;
template <class Epi> struct EpiSplit {
    static constexpr bool PERM = Epi::PERM, AFTER_DRAIN = false;
    Epi e; float* slab; unsigned* cnt; int nprod; int pskip;
    DI void init_acc(pg8::f32x4 (&acc)[2][2][4][2], const pg8::Unit& u) const {
#pragma unroll
        for (int i = 0; i < 32; ++i) acc[i >> 4][(i >> 3) & 1][(i >> 1) & 3][i & 1] = (pg8::f32x4){0.f, 0.f, 0.f, 0.f};
        if (u.role != 2 || (pskip & 1)) return;
        const int tid = threadIdx.x, su = __builtin_amdgcn_readfirstlane(u.slot); const unsigned want = 8u * (unsigned)nprod;
#ifdef HIPEMU
        while (cnt[su * 8] < want) emu::yield();
#else
        { unsigned sp = 0; while ((unsigned)__builtin_amdgcn_readfirstlane(__hip_atomic_load(cnt + su * 8, __ATOMIC_RELAXED, __HIP_MEMORY_SCOPE_AGENT)) < want) { __builtin_amdgcn_s_sleep(2); if (++sp > (1u << 24)) break; }
          __builtin_amdgcn_fence(__ATOMIC_ACQUIRE, "agent"); VM_WAIT(); }
        const __amdgpu_buffer_rsrc_t rs = __builtin_amdgcn_make_buffer_rsrc((void*)slab, 0, (int)((size_t)SLAB_PARTS * 262144), 0x00020000);
#endif
        for (int j = 0; j < nprod; ++j) { const int part = su * nprod + j;
#pragma unroll
            for (int i = 0; i < 32; ++i) {
#ifdef HIPEMU
                acc[i >> 4][(i >> 3) & 1][(i >> 1) & 3][i & 1] += ((const f32x4*)slab)[(size_t)part * 16384 + i * 512 + tid];
#else
                acc[i >> 4][(i >> 3) & 1][(i >> 1) & 3][i & 1] += __builtin_bit_cast(pg8::f32x4, __builtin_amdgcn_raw_buffer_load_b128(rs, tid * 16, part * 262144 + i * 8192, 16));
#endif
            } }
    }
    DI void operator()(pg8::f32x4 (&acc)[2][2][4][2], const pg8::Unit& u, int wr, int wc, int fr, int fq) const {
        if (u.role != 1) { e(acc, u, wr, wc, fr, fq); return; }
        if (pskip & 2) return;
        const int tid = threadIdx.x, part = __builtin_amdgcn_readfirstlane(u.slot);
#ifndef HIPEMU
        const __amdgpu_buffer_rsrc_t rs = __builtin_amdgcn_make_buffer_rsrc((void*)slab, 0, (int)((size_t)SLAB_PARTS * 262144), 0x00020000);
#endif
#pragma unroll
        for (int i = 0; i < 32; ++i) { const pg8::f32x4 v = acc[i >> 4][(i >> 3) & 1][(i >> 1) & 3][i & 1];
#ifdef HIPEMU
            ((f32x4*)slab)[(size_t)part * 16384 + i * 512 + tid] = v;
#else
            __builtin_amdgcn_raw_buffer_store_b128(__builtin_bit_cast(u32x4, v), rs, tid * 16, part * 262144 + i * 8192, 16);
#endif
        }
        VM_WAIT();
        if ((tid & 63) == 0) {
#ifdef HIPEMU
            cnt[(part / nprod) * 8] += 1u;
#else
            __hip_atomic_fetch_add(cnt + (part / nprod) * 8, 1u, __ATOMIC_RELAXED, __HIP_MEMORY_SCOPE_AGENT);
#endif
        }
    }
};

#ifndef HIPEMU
#define XB_TMO      128
#define XB_XCNT(j)  (256  + 64 * (j))
#define XB_XSUB(j)  (1280 + 64 * (j))
#define XB_XGEN(j)  (2304 + 64 * (j))
#define XB_TOP      3328
#define XB_TOPGEN   3392
#define XCD_BAR_WORDS 3456
#define XB_SPIN_CAP (1u << 22)

__device__ __forceinline__ unsigned xb_ld(unsigned* p)              { return __hip_atomic_load(p, __ATOMIC_RELAXED, __HIP_MEMORY_SCOPE_AGENT); }
__device__ __forceinline__ unsigned xb_add(unsigned* p, unsigned v) { return __hip_atomic_fetch_add(p, v, __ATOMIC_RELAXED, __HIP_MEMORY_SCOPE_AGENT); }
__device__ __forceinline__ unsigned xb_xcc_id() { return (unsigned)__builtin_amdgcn_s_getreg((3 << 11) | 20) & 0xFu; }
#define XB_SPIN(cond, bar) do { unsigned _sp = 0; while (cond) { __builtin_amdgcn_s_sleep(1); \
    if ((++_sp & 255u) == 0u) { if (xb_ld(&(bar)[XB_TMO])) break; if (_sp > XB_SPIN_CAP) { atomicAdd(&(bar)[XB_TMO], 1u); break; } } } } while (0)

struct XcdBarrier {
    unsigned* bar; unsigned x;
    volatile LAS unsigned* st;
};
__device__ __forceinline__ XcdBarrier xcd_barrier_post(unsigned* bar, volatile LAS unsigned* st) {
    XcdBarrier b; b.bar = bar; b.x = xb_xcc_id(); b.st = st;
    if (threadIdx.x == 0) (void)xb_add(&bar[XB_XCNT(b.x)], 1u);
    return b;
}
__device__ __forceinline__ void xcd_barrier_complete(unsigned* bar, unsigned x, unsigned& nloc, unsigned& nx) {
    const unsigned G = gridDim.x * gridDim.y * gridDim.z;
    unsigned sum, cnt, mine, sp = 0u;
    for (;;) {
        sum = 0u; cnt = 0u; mine = 0u;
#pragma unroll
        for (unsigned j = 0; j < 16; ++j) { const unsigned c = xb_ld(&bar[XB_XCNT(j)]); sum += c; cnt += (c > 0u) ? 1u : 0u; mine = (j == x) ? c : mine; }
        if (sum == G) break;
        __builtin_amdgcn_s_sleep(1);
        if ((++sp & 255u) == 0u) { if (xb_ld(&bar[XB_TMO])) break; if (sp > XB_SPIN_CAP) { atomicAdd(&bar[XB_TMO], 1u); break; } }
    }
    nloc = mine > 0u ? mine : 1u; nx = cnt > 0u ? cnt : 1u;
}
__device__ __forceinline__ void xcd_barrier(const XcdBarrier& b) {
    asm volatile("s_waitcnt vmcnt(0)" ::: "memory");
    __syncthreads();
    if (threadIdx.x == 0) {
        unsigned* bar = b.bar;
        __builtin_amdgcn_s_waitcnt(0);
        unsigned nloc = b.st[0], nx = b.st[1];
        if (nloc == 0u) { xcd_barrier_complete(bar, b.x, nloc, nx); b.st[0] = nloc; b.st[1] = nx; }
        const unsigned old = xb_add(&bar[XB_XSUB(b.x)], 1u);
        const unsigned gen = old / nloc;
        if (old + 1u == (gen + 1u) * nloc) {
            __builtin_amdgcn_fence(__ATOMIC_RELEASE, "agent");
            asm volatile("s_waitcnt vmcnt(0)" ::: "memory");
            const unsigned og = xb_add(&bar[XB_TOP], 1u);
            const unsigned tg = og / nx;
            if (og + 1u == (tg + 1u) * nx) xb_add(&bar[XB_TOPGEN], 1u);
            else XB_SPIN(xb_ld(&bar[XB_TOPGEN]) == tg, bar);
            __builtin_amdgcn_fence(__ATOMIC_ACQUIRE, "agent");
            xb_add(&bar[XB_XGEN(b.x)], 1u);
            asm volatile("s_waitcnt vmcnt(0)" ::: "memory");
        } else {
            XB_SPIN(xb_ld(&bar[XB_XGEN(b.x)]) == gen, bar);
            __builtin_amdgcn_fence(__ATOMIC_ACQUIRE, "agent");
            asm volatile("s_waitcnt vmcnt(0)" ::: "memory");
        }
    }
    __syncthreads();
}
#else
#define XCD_BAR_WORDS 3456
struct XcdBarrier { int dummy; };
inline void xcd_barrier(const XcdBarrier&) { emu_grid_barrier(); }
#endif

struct Args { const float* in[N_IN]; float* out; unsigned char* ws; int ph_lo, ph_hi; };
#ifdef HIPEMU
typedef const Args* ArgsP;
#else
typedef const __attribute__((address_space(4))) Args* ArgsP;
#endif
struct Frame {
    LAS unsigned char* lds;
    int tid, lane, wave, G, bx;
    ArgsP ap; float* out; unsigned char* ws;
    DI const float* inp(int i) const { return ap->in[i]; }
    DI void refresh() {
#ifndef HIPEMU
        asm volatile("" : "+s"(ap) :: "memory"); asm volatile("" : "+v"(tid));
        lane = tid & 63; wave = __builtin_amdgcn_readfirstlane(tid >> 6);
#endif
        out = ap->out; ws = ap->ws; }
};
#define WSP(T, off) ((T*)(F.ws + (off)))

DI void transpose_tile(const float* W, int ldsrc, int k0, int n0, bf16* dst_row0, int lddst, LAS float* scr, int lane) {
#pragma unroll 8
    for (int i = 0; i < 32; ++i) { const int kk = 2 * i + (lane >> 5); scr[kk * 33 + (lane & 31)] = NT_LD(W + (size_t)(k0 + kk) * ldsrc + n0 + (lane & 31)); }
    WSYNC();
    const int c = lane & 7;
#pragma unroll
    for (int j = 0; j < 4; ++j) { const int n = (lane >> 3) + 8 * j; const LAS float* s = scr + (8 * c) * 33 + n;
        u32x4 o; o.x = pk2(s[0 * 33], s[1 * 33]); o.y = pk2(s[2 * 33], s[3 * 33]); o.z = pk2(s[4 * 33], s[5 * 33]); o.w = pk2(s[6 * 33], s[7 * 33]);
        *(u32x4*)(dst_row0 + (size_t)n * lddst + k0 + 8 * c) = o; }
    WSYNC();
}
DI void transpose_tile_fp8(const float* W, int ldsrc, int k0, int n0, unsigned char* dst_row0, int lddst, float scale, LAS float* scr, int lane) {
#pragma unroll 8
    for (int i = 0; i < 32; ++i) { const int kk = 2 * i + (lane >> 5); scr[kk * 33 + (lane & 31)] = NT_LD(W + (size_t)(k0 + kk) * ldsrc + n0 + (lane & 31)) * scale; }
    WSYNC();
    const int c = lane & 7;
#pragma unroll
    for (int j = 0; j < 4; ++j) { const int n = (lane >> 3) + 8 * j; const LAS float* s = scr + (8 * c) * 33 + n;
        u32x2 o; o.x = pk4_fp8(s[0 * 33], s[1 * 33], s[2 * 33], s[3 * 33]); o.y = pk4_fp8(s[4 * 33], s[5 * 33], s[6 * 33], s[7 * 33]);
        *(u32x2*)(dst_row0 + (size_t)n * lddst + k0 + 8 * c) = o; }
    WSYNC();
}
DI void tr_plain(const float* W, int K, int N, bf16* Wt, int item, LAS float* scr, int lane) {
    const int nblk = N / 32, kb = item / nblk, nb = item % nblk;
    transpose_tile(W, N, 64 * kb, 32 * nb, Wt + (size_t)(32 * nb) * K, K, scr, lane);
}
DI void p0_prologue(Frame& F) {
    const int gw = F.bx * NWAVES + F.wave, NGW = F.G * NWAVES;
    const size_t gt = (size_t)F.bx * NTHR + F.tid, NGT = (size_t)F.G * NTHR;
    { float* rp = WSP(float, WS_ROPE);
      for (size_t i = gt; i < 64 * 32; i += NGT) { const int pos = (int)(i / 32), fi = (int)(i % 32);
          const float inv = powf(10000.0f, -(float)fi / 32.0f); const float ang = (float)pos * inv; rp[2 * i] = cosf(ang); rp[2 * i + 1] = sinf(ang); } }
    { LAS float* scr = (LAS float*)(F.lds + F.wave * 16384);
      constexpr int T_FI = (D / 64) * (2 * DFF / 32), T_FO = (DFF / 64) * (D / 32), T_QKV = (D / 64) * (QKVD / 32), T_DD = (D / 64) * (D / 32), T_MI = (D / 64) * (MIN / 32);
      constexpr int NT = 8 * T_FI + 8 * T_FO + 2 * T_QKV + 2 * T_DD + T_MI + T_DD + 3 * T_DD + T_DD;
      for (int it = gw; it < NT; it += NGW) {
          int r = it;
          if (r < 8 * T_FI) { const int hl = r / T_FI; r %= T_FI; const float* W = F.inp(I_FWI) + (size_t)hl * D * 2 * DFF; bf16* Wt = WSP(bf16, WS_WFI + hl * SZ_WFI);
              const int nblk = 2 * DFF / 32, kb = r / nblk, nb = r % nblk, n0 = 32 * nb;
              const int nn = n0 < DFF ? n0 : n0 - DFF; const int drow = 256 * (nn / 128) + (n0 < DFF ? 0 : 128) + nn % 128;
              if (hl >= FFN_IN_FP8_FROM) transpose_tile_fp8(W, 2 * DFF, 64 * kb, n0, (unsigned char*)Wt + (size_t)drow * D, D, WFI_SCALE, scr, F.lane);
              else transpose_tile(W, 2 * DFF, 64 * kb, n0, Wt + (size_t)drow * D, D, scr, F.lane);
              continue; }
          r -= 8 * T_FI;
#if FFN_OUT_FP8
          if (r < 8 * T_FO) { const int hl = r / T_FO; r %= T_FO; const int nblk = D / 32, kb = r / nblk, nb = r % nblk;
              transpose_tile_fp8(F.inp(I_FWO) + (size_t)hl * DFF * D, D, 64 * kb, 32 * nb, WSP(unsigned char, WS_WFO + hl * SZ_WFO) + (size_t)(32 * nb) * DFF, DFF, WFO_SCALE, scr, F.lane); continue; }
#else
          if (r < 8 * T_FO) { const int hl = r / T_FO; r %= T_FO; tr_plain(F.inp(I_FWO) + (size_t)hl * DFF * D, DFF, D, WSP(bf16, WS_WFO + hl * SZ_WFO), r, scr, F.lane); continue; }
#endif
          r -= 8 * T_FO;
          if (r < 2 * T_QKV) { const int s = r / T_QKV; r %= T_QKV; tr_plain(F.inp(I_AQKV) + (size_t)s * D * QKVD, D, QKVD, WSP(bf16, WS_WQKV + s * SZ_WQKV), r, scr, F.lane); continue; }
          r -= 2 * T_QKV;
          if (r < 2 * T_DD) { const int s = r / T_DD; r %= T_DD; tr_plain(F.inp(I_AWO) + (size_t)s * D * D, D, D, WSP(bf16, WS_WAO + s * SZ_WDD), r, scr, F.lane); continue; }
          r -= 2 * T_DD;
          if (r < T_MI) { tr_plain(F.inp(I_MWI), D, MIN, WSP(bf16, WS_WMI), r, scr, F.lane); continue; }
          r -= T_MI;
          if (r < T_DD) { tr_plain(F.inp(I_MWO), D, D, WSP(bf16, WS_WMO), r, scr, F.lane); continue; }
          r -= T_DD;
          if (r < 3 * T_DD) { const int p = r / T_DD; r %= T_DD; tr_plain(F.inp(I_RWRKV) + (size_t)p * D * D, D, D, WSP(bf16, WS_WRK) + (size_t)p * D * D, r, scr, F.lane); continue; }
          r -= 3 * T_DD;
          tr_plain(F.inp(I_RWO), D, D, WSP(bf16, WS_WRO), r, scr, F.lane);
      } }
    {
      bf16* g = WSP(bf16, WS_WMI) + (size_t)MIN * D; const float* wg = F.inp(I_MWG);
      for (size_t i = gt; i < (size_t)256 * D / 2; i += NGT) { const int n = (int)(i / (D / 2)), k = 2 * (int)(i % (D / 2));
          const float a = n < NGATE ? wg[(size_t)k * NGATE + n] : 0.f, b = n < NGATE ? wg[(size_t)(k + 1) * NGATE + n] : 0.f; *(unsigned*)(g + (size_t)n * D + k) = pk2(a, b); }
      bf16* la = WSP(bf16, WS_WRK) + (size_t)3 * D * D; const float* wA = F.inp(I_RWA); const float* aA = F.inp(I_RAA); const float* gA = F.inp(I_RGA);
      for (size_t i = gt; i < (size_t)768 * D / 2; i += NGT) { const int n = (int)(i / (D / 2)), k = 2 * (int)(i % (D / 2)); const int t = n / 256, c = n % 256; float a = 0.f, b = 0.f;
          if (t == 2) { a = gA[(size_t)k * LG + c]; b = gA[(size_t)(k + 1) * LG + c]; }
          else if (c < 2 * LW) { const float* src = (t == 0 ? wA : aA) + (size_t)(c / LW) * D * LW; const int cc = c % LW; a = src[(size_t)k * LW + cc]; b = src[(size_t)(k + 1) * LW + cc]; }
          *(unsigned*)(la + (size_t)n * D + k) = pk2(a, b); }
      bf16* lb = WSP(bf16, WS_WLB); const float* wB = F.inp(I_RWB); const float* aB = F.inp(I_RAB); const float* gB = F.inp(I_RGB);
      for (size_t i = gt; i < (size_t)5 * D * 128; i += NGT) { const int j = (int)(i / ((size_t)D * 128)); const int rem = (int)(i % ((size_t)D * 128)); const int n = rem / 128, k = 2 * (rem % 128); float a = 0.f, b = 0.f;
          if (j == 4) { a = gB[(size_t)k * D + n]; b = gB[(size_t)(k + 1) * D + n]; }
          else { const int z = j & 1; const float* src = (j < 2 ? wB : aB) + (size_t)z * LW * D; const int kk = k - LW * z; if (kk >= 0 && kk < LW) { a = src[(size_t)kk * D + n]; b = src[(size_t)(kk + 1) * D + n]; } }
          *(unsigned*)(lb + ((size_t)j * D + n) * 256 + k) = pk2(a, b); }
    }
    { __syncthreads();
      LAS float* sc = (LAS float*)F.lds;
      LAS float* red = (LAS float*)(F.lds + NCOND * D * 4);
      for (int i = F.tid; i < NCOND * D; i += NTHR) { const int c = i / D, k = i % D; const float v = c == 0 ? F.inp(I_CCTX)[k] : F.inp(I_C)[(size_t)(c - 1) * D + k]; sc[i] = siluf_(v); }
      __syncthreads();
      constexpr int NCG = NMOD * D / 64, NITEM = DEPTH * NCG;
      for (int it = F.bx; it < NITEM; it += F.G) {
          const int layer = it / NCG, cg = it % NCG;
          const float* W = F.inp(I_MODW) + (size_t)layer * D * NMOD * D + cg * 64 + F.lane;
          float acc[NCOND];
#pragma unroll
          for (int c = 0; c < NCOND; ++c) acc[c] = 0.f;
          const int k0 = F.wave * (D / 8);
#pragma unroll 8
          for (int k = k0; k < k0 + D / 8; ++k) { const float w = NT_LD(W + (size_t)k * NMOD * D);
#pragma unroll
              for (int c = 0; c < NCOND; ++c) acc[c] += w * sc[c * D + k]; }
#pragma unroll
          for (int c = 0; c < NCOND; ++c) red[(F.wave * NCOND + c) * 64 + F.lane] = acc[c];
          __syncthreads();
          for (int i = F.tid; i < NCOND * 64; i += NTHR) { const int c = i / 64, n = i % 64; float s2 = F.inp(I_MODB)[(size_t)layer * NMOD * D + cg * 64 + n];
#pragma unroll
              for (int w = 0; w < 8; ++w) s2 += red[(w * NCOND + c) * 64 + n];
              WSP(float, WS_MOD)[((size_t)layer * NCOND + c) * NMOD * D + cg * 64 + n] = s2; }
          __syncthreads();
      } }
}

template <int NV> DI void load_mod_row(const float* xr, const float* gp, const float* shp, const float* scp, int lane, f32x4 (&v)[NV]) {
    float ss = 0.f;
#pragma unroll
    for (int j = 0; j < NV; ++j) { v[j] = *(const f32x4*)(xr + (j * 64 + lane) * 4); ss += (v[j].x * v[j].x + v[j].y * v[j].y) + (v[j].z * v[j].z + v[j].w * v[j].w); }
    const float rstd = 1.0f / sqrtf(wave_sum(ss) * (1.0f / D) + EPS);
#pragma unroll
    for (int j = 0; j < NV; ++j) { const int c = (j * 64 + lane) * 4; const f32x4 g = *(const f32x4*)(gp + c), sh = *(const f32x4*)(shp + c), sc = *(const f32x4*)(scp + c);
        v[j] = v[j] * rstd * g * (sc + 1.0f) + sh; }
}
DI const float* x_in_row(const Frame& F, int row) { return row < MC ? F.inp(I_XP) + (size_t)row * D : F.inp(I_XS) + (size_t)(row - MC) * D; }
DI void phase_norm(Frame& F, int layer, int which  , bool first, bool fp8out = false) {
    const int gw = F.bx * NWAVES + F.wave, NGW = F.G * NWAVES; constexpr int NV = D / 256;
    const float* X = F.out; bf16* XN = WSP(bf16, WS_XN);
    const float* gp = F.inp(I_NORMG) + ((size_t)layer * 3 + which) * D;
    f32x4 cur[NV], nxt[NV], gs[NV], sh[NV]; int ccond = -1;
    if (gw < M) {
#pragma unroll
        for (int j = 0; j < NV; ++j) cur[j] = *(const f32x4*)((first ? x_in_row(F, gw) : X + (size_t)gw * D) + (j * 64 + F.lane) * 4); }
    for (int row = gw; row < M; row += NGW) {
        const int nrow = row + NGW < M ? row + NGW : row;
#pragma unroll
        for (int j = 0; j < NV; ++j) nxt[j] = *(const f32x4*)((first ? x_in_row(F, nrow) : X + (size_t)nrow * D) + (j * 64 + F.lane) * 4);
        const int cond = cond_of_row(row);
        if (cond != ccond) { ccond = cond; const float* mp = WSP(float, WS_MOD) + (((size_t)layer * NCOND + cond) * NMOD + 3 * which) * D;
#pragma unroll
            for (int j = 0; j < NV; ++j) { const int c = (j * 64 + F.lane) * 4; gs[j] = *(const f32x4*)(gp + c) * (*(const f32x4*)(mp + D + c) + 1.0f); sh[j] = *(const f32x4*)(mp + c); } }
        float ss = 0.f;
#pragma unroll
        for (int j = 0; j < NV; ++j) ss += (cur[j].x * cur[j].x + cur[j].y * cur[j].y) + (cur[j].z * cur[j].z + cur[j].w * cur[j].w);
        const float rstd = 1.0f / sqrtf(wave_sum(ss) * (1.0f / D) + EPS);
#pragma unroll
        for (int j = 0; j < NV; ++j) { const f32x4 v = cur[j] * rstd * gs[j] + sh[j];
            if (fp8out) *(unsigned*)((unsigned char*)XN + (size_t)row * D + (j * 64 + F.lane) * 4) = pk4_fp8(v.x, v.y, v.z, v.w);
            else { u32x2 w; w.x = pk2(v.x, v.y); w.y = pk2(v.z, v.w); *(u32x2*)(XN + (size_t)row * D + (j * 64 + F.lane) * 4) = w; }
            cur[j] = nxt[j]; }
    }
}
DI float row_rstd(const float* xr, int lane) {
    float ss = 0.f;
#pragma unroll
    for (int j = 0; j < D / 256; ++j) { const f32x4 v = *(const f32x4*)(xr + (j * 64 + lane) * 4); ss += (v.x * v.x + v.y * v.y) + (v.z * v.z + v.w * v.w); }
    return 1.0f / sqrtf(wave_sum(ss) * (1.0f / D) + EPS);
}
DI void phase_norm_rwkv(Frame& F, int layer) {
    const int gw = F.bx * NWAVES + F.wave, NGW = F.G * NWAVES;
    const float* X = F.out; bf16* XS = WSP(bf16, WS_XN);
    const float* gp = F.inp(I_NORMG) + ((size_t)layer * 3 + 1) * D; const float* mu = F.inp(I_RMU);
    for (int row = gw; row < M; row += NGW) {
        const float* mp = WSP(float, WS_MOD) + (((size_t)layer * NCOND + cond_of_row(row)) * NMOD + 3) * D;
        const int t = row < MC ? row % TC : (row - MC) % TL, T = row < MC ? TC : TL;
        const bool hasm = t > 0, hasp = t < T - 1;
        const float* x0 = X + (size_t)row * D; const float* xm = hasm ? x0 - D : x0; const float* xp = hasp ? x0 + D : x0;
        const float r0 = row_rstd(x0, F.lane), rm = hasm ? row_rstd(xm, F.lane) : 0.f, rp = hasp ? row_rstd(xp, F.lane) : 0.f;
#pragma unroll 1
        for (int j = 0; j < D / 256; ++j) { const int c = (j * 64 + F.lane) * 4;
            const f32x4 g = *(const f32x4*)(gp + c), sh = *(const f32x4*)(mp + c), sc = *(const f32x4*)(mp + D + c) + 1.0f;
            const f32x4 gs = g * sc;
            const f32x4 h0 = *(const f32x4*)(x0 + c) * r0 * gs + sh;
            const f32x4 hm = hasm ? *(const f32x4*)(xm + c) * rm * gs + sh : (f32x4){0.f, 0.f, 0.f, 0.f};
            const f32x4 hp = hasp ? *(const f32x4*)(xp + c) * rp * gs + sh : (f32x4){0.f, 0.f, 0.f, 0.f};
            const f32x4 cs = (hm + hp) * 0.5f - h0;
#pragma unroll
            for (int p = 0; p < 6; ++p) { const f32x4 m = *(const f32x4*)(mu + (size_t)p * D + c); const f32x4 o = h0 + cs * m;
                u32x2 w; w.x = pk2(o.x, o.y); w.y = pk2(o.z, o.w); *(u32x2*)(XS + ((size_t)p * M + row) * D + c) = w; } }
    }
}

DI void phase_qknorm(Frame& F, int slot) {
    const int gw = F.bx * NWAVES + F.wave, NGW = F.G * NWAVES;
    bf16* QKV = WSP(bf16, WS_QKV); bf16* KB = WSP(bf16, WS_KB); bf16* VB = WSP(bf16, WS_VB); const float* rope = WSP(float, WS_ROPE);
    const float* qn = F.inp(I_AQN) + (size_t)slot * HD; const float* kn = F.inp(I_AKN) + (size_t)slot * HD;
    const int e0 = 2 * F.lane; const float qn0 = qn[e0], qn1 = qn[e0 + 1], kn0 = kn[e0], kn1 = kn[e0 + 1];
    for (int row = gw; row < M; row += NGW) {
        const bool lat = row >= MC; const int t = lat ? (row - MC) % TL : row % TC, b = lat ? (row - MC) / TL : row / TC;
        float c0 = 1.f, s0 = 0.f, c1 = 1.f, s1 = 0.f;
        if (lat) { const int pos = (e0 >> 6) ? (t % GRIDW) : (t / GRIDW); const float* rp = rope + ((size_t)pos * 32 + (e0 & 31)) * 2; c0 = rp[0]; s0 = rp[1]; c1 = rp[2]; s1 = rp[3];
            if ((e0 & 63) < 32) { s0 = -s0; s1 = -s1; } }
        for (int hh = 0; hh < AH + 2 * AKV; ++hh) {
            const unsigned w = *(const unsigned*)(QKV + (size_t)row * QKVD + hh * HD + e0); float x0 = bflo(w), x1 = bfhi(w);
            if (hh < AH + AKV) {
                const float rstd = 1.0f / sqrtf(wave_sum(x0 * x0 + x1 * x1) * (1.0f / HD) + EPS);
                x0 *= rstd * (hh < AH ? qn0 : kn0); x1 *= rstd * (hh < AH ? qn1 : kn1);
                const float p0 = __shfl_xor(x0, 16), p1 = __shfl_xor(x1, 16);
                if (lat) { x0 = x0 * c0 + p0 * s0; x1 = x1 * c1 + p1 * s1; }
                if (hh < AH) *(unsigned*)(QKV + (size_t)row * QKVD + hh * HD + e0) = pk2(x0, x1);
                else { const int kvh = hh - AH; *(unsigned*)(KB + (size_t)row * (AKV * HD) + kvh * HD + e0) = pk2(x0, x1);
                    if (!lat) NT_ST((f32x2*)(F.out + O_CK + ((((size_t)b * NSLOT_ATTN + slot) * TC + t) * AKV + kvh) * HD + e0), ((f32x2){x0, x1})); }
            } else { const int kvh = hh - AH - AKV; *(unsigned*)(VB + (size_t)row * (AKV * HD) + kvh * HD + e0) = w;
                if (!lat) NT_ST((f32x2*)(F.out + O_CV + ((((size_t)b * NSLOT_ATTN + slot) * TC + t) * AKV + kvh) * HD + e0), ((f32x2){x0, x1})); }
        }
    }
}

constexpr int ATT_KS = 136, ATT_VS = 144;
#ifdef HIPEMU
DI u32x2 lds_read_tr16(const bf16* p) {
    emu::WaveX& w = emu::wavex[emu::wave_id()]; const int lane = threadIdx.x & 63; memcpy(w.slot[lane], &p, sizeof(p)); emu::wave_bar();
    const int g = lane >> 4, i = lane & 15; unsigned short e[4];
    for (int q = 0; q < 4; ++q) { const bf16* a; memcpy(&a, w.slot[16 * g + 4 * q + (i >> 2)], sizeof(a)); e[q] = a[i & 3]; }
    emu::wave_bar(); u32x2 r; r.x = e[0] | ((unsigned)e[1] << 16); r.y = e[2] | ((unsigned)e[3] << 16); return r;
}
#else
typedef short v4i16_t __attribute__((ext_vector_type(4)));
DI u32x2 lds_read_tr16(const LAS bf16* p) { return __builtin_bit_cast(u32x2, __builtin_amdgcn_ds_read_tr16_b64_v4i16((LAS v4i16_t*)p)); }
#endif
struct AttnRegs { unsigned kw[2][4], vw[2][4]; };
DI void attn_fetch(AttnRegs& R, int tid, const bf16* kb, const bf16* vb, int ldb, const float* kf, const float* vf, int ldf) {
#pragma unroll
    for (int i = 0; i < 2; ++i) { const int c = tid + NTHR * i, key = c >> 4, c8 = (c & 15) * 8;
        if (kb) { const u32x4 a = *(const u32x4*)(kb + (size_t)key * ldb + c8), b = *(const u32x4*)(vb + (size_t)key * ldb + c8);
            R.kw[i][0] = a.x; R.kw[i][1] = a.y; R.kw[i][2] = a.z; R.kw[i][3] = a.w; R.vw[i][0] = b.x; R.vw[i][1] = b.y; R.vw[i][2] = b.z; R.vw[i][3] = b.w; }
        else { const f32x4 a0 = *(const f32x4*)(kf + (size_t)key * ldf + c8), a1 = *(const f32x4*)(kf + (size_t)key * ldf + c8 + 4), b0 = *(const f32x4*)(vf + (size_t)key * ldf + c8), b1 = *(const f32x4*)(vf + (size_t)key * ldf + c8 + 4);
            R.kw[i][0] = pk2(a0.x, a0.y); R.kw[i][1] = pk2(a0.z, a0.w); R.kw[i][2] = pk2(a1.x, a1.y); R.kw[i][3] = pk2(a1.z, a1.w);
            R.vw[i][0] = pk2(b0.x, b0.y); R.vw[i][1] = pk2(b0.z, b0.w); R.vw[i][2] = pk2(b1.x, b1.y); R.vw[i][3] = pk2(b1.z, b1.w); } }
}
DI void attn_stash(const AttnRegs& R, int tid, LAS bf16* Ks, LAS bf16* Vt) {
#pragma unroll
    for (int i = 0; i < 2; ++i) { const int c = tid + NTHR * i, key = c >> 4, c8 = (c & 15) * 8;
        *(LAS u32x4*)(Ks + key * ATT_KS + c8) = (u32x4){R.kw[i][0], R.kw[i][1], R.kw[i][2], R.kw[i][3]};
        *(LAS u32x4*)(Vt + key * ATT_VS + c8) = (u32x4){R.vw[i][0], R.vw[i][1], R.vw[i][2], R.vw[i][3]}; }
}
DI void phase_attn(Frame& F, int slot) {
    LAS bf16* Ks = (LAS bf16*)F.lds; LAS bf16* Vt = (LAS bf16*)(F.lds + 64 * ATT_KS * 2);
    const bf16* QKV = WSP(bf16, WS_QKV); const bf16* KB = WSP(bf16, WS_KB); const bf16* VB = WSP(bf16, WS_VB); bf16* OB = WSP(bf16, WS_OB);
    const float* sink = F.inp(I_ASINK) + (size_t)slot * AH;
    constexpr int U_LAT = BL * AH * (TL / 128), U_CTX = BC * AH * (TC / 128);
    const int l15 = F.lane & 15, kq = F.lane >> 4; const float scale = 0.08838834764831845f;
    for (int ui = F.bx; ui < U_LAT + U_CTX; ui += F.G) {
        const bool lat = ui < U_LAT; int r = lat ? ui : ui - U_LAT; const int T = lat ? TL : TC, nqt = T / 128;
        const int qt = r % nqt; r /= nqt; const int h = r % AH, b = r / AH, kvh = h / AG;
        const int rowbase = lat ? MC + b * TL : b * TC, t0 = qt * 128, tq = t0 + 16 * F.wave + l15;
        bf16x8 qf[4];
#pragma unroll
        for (int ks = 0; ks < 4; ++ks) qf[ks] = *(const bf16x8*)(QKV + (size_t)(rowbase + tq) * QKVD + h * HD + ks * 32 + kq * 8);
        float m_run = sink[h], l_run = kq == 0 ? 1.0f : 0.0f;
        f32x4 o[8];
#pragma unroll
        for (int dt = 0; dt < 8; ++dt) o[dt] = (f32x4){0.f, 0.f, 0.f, 0.f};
        const int w_lo = lat ? (t0 - 128 > 0 ? t0 - 128 : 0) : 0, w_hi = lat ? (t0 + 256 < TL ? t0 + 256 : TL) : TC;
        const int n_win = (w_hi - w_lo) / 64, n_tiles = n_win + (lat ? PAST / 64 : 0);
        AttnRegs R;
#define ATT_FETCH(ti_) do { const bool win_ = (ti_) < n_win; const int k0_ = win_ ? w_lo + (ti_) * 64 : ((ti_) - n_win) * 64; \
            if (win_) attn_fetch(R, F.tid, KB + (size_t)(rowbase + k0_) * (AKV * HD) + kvh * HD, VB + (size_t)(rowbase + k0_) * (AKV * HD) + kvh * HD, AKV * HD, nullptr, nullptr, 0); \
            else { const size_t off_ = ((((size_t)b * NSLOT_ATTN + slot) * PAST + k0_) * AKV + kvh) * HD; attn_fetch(R, F.tid, nullptr, nullptr, 0, F.inp(I_CK) + off_, F.inp(I_CV) + off_, AKV * HD); } } while (0)
        ATT_FETCH(0);
        for (int ti = 0; ti < n_tiles; ++ti) {
            const bool win = ti < n_win; const int k0 = win ? w_lo + ti * 64 : (ti - n_win) * 64;
            __syncthreads();
            attn_stash(R, F.tid, Ks, Vt);
            if (ti + 1 < n_tiles) ATT_FETCH(ti + 1);
            __syncthreads();
            f32x4 s[4];
#pragma unroll
            for (int kt = 0; kt < 4; ++kt) { s[kt] = (f32x4){0.f, 0.f, 0.f, 0.f};
#pragma unroll
                for (int ks = 0; ks < 4; ++ks) { const bf16x8 a = *(const LAS bf16x8*)(Ks + (kt * 16 + l15) * ATT_KS + ks * 32 + kq * 8);
                    s[kt] = __builtin_amdgcn_mfma_f32_16x16x32_bf16(a, qf[ks], s[kt], 0, 0, 0); } }
            float tmax = -3.0e38f;
#pragma unroll
            for (int kt = 0; kt < 4; ++kt)
#pragma unroll
                for (int j = 0; j < 4; ++j) { float v = s[kt][j] * scale;
                    if (lat && win) { const int tk = k0 + kt * 16 + kq * 4 + j; const int d = tq - tk; if (d > 128 || d < -128) v = -1.0e30f; }
                    s[kt][j] = v; tmax = fmaxf(tmax, v); }
            tmax = fmaxf(tmax, __shfl_xor(tmax, 16)); tmax = fmaxf(tmax, __shfl_xor(tmax, 32));
            const float m_new = fmaxf(m_run, tmax), alpha = __expf(m_run - m_new); m_run = m_new;
            float psum = 0.f;
#pragma unroll
            for (int kt = 0; kt < 4; ++kt)
#pragma unroll
                for (int j = 0; j < 4; ++j) { const float p = __expf(s[kt][j] - m_new); s[kt][j] = p; psum += p; }
            l_run = l_run * alpha + psum;
#pragma unroll
            for (int dt = 0; dt < 8; ++dt) o[dt] *= alpha;
#pragma unroll
            for (int ks = 0; ks < 2; ++ks) {
                u32x4 pw; pw.x = pk2(s[2 * ks][0], s[2 * ks][1]); pw.y = pk2(s[2 * ks][2], s[2 * ks][3]); pw.z = pk2(s[2 * ks + 1][0], s[2 * ks + 1][1]); pw.w = pk2(s[2 * ks + 1][2], s[2 * ks + 1][3]);
                bf16x8 pb; __builtin_memcpy(&pb, &pw, 16);
#pragma unroll
                for (int dt = 0; dt < 8; ++dt) { const LAS bf16* vp = Vt + (kq * 4 + (l15 >> 2)) * ATT_VS + dt * 16 + 4 * (l15 & 3);
                    const u32x2 v0 = lds_read_tr16(vp + (2 * ks) * 16 * ATT_VS), v1 = lds_read_tr16(vp + (2 * ks + 1) * 16 * ATT_VS);
                    u32x4 vw = (u32x4){v0.x, v0.y, v1.x, v1.y}; bf16x8 va; __builtin_memcpy(&va, &vw, 16);
                    o[dt] = __builtin_amdgcn_mfma_f32_16x16x32_bf16(va, pb, o[dt], 0, 0, 0); }
            }
        }
        l_run += __shfl_xor(l_run, 16); l_run += __shfl_xor(l_run, 32);
        const float inv = 1.0f / l_run;
        bf16* orow = OB + (size_t)(rowbase + tq) * D + h * HD + kq * 4;
#pragma unroll
        for (int dt = 0; dt < 8; ++dt) { u32x2 w; w.x = pk2(o[dt][0] * inv, o[dt][1] * inv); w.y = pk2(o[dt][2] * inv, o[dt][3] * inv); *(u32x2*)(orow + dt * 16) = w; }
    }
    __syncthreads();
}

constexpr int ML_QS = 136, ML_SS = 72;
DI float log_sigmoidf_(float x) { return x < 0.f ? x - log1pf(__expf(x)) : -log1pf(__expf(-x)); }
DI float oct_sum(float v) {
#ifdef HIPEMU
    v += __shfl_xor(v, 1); v += __shfl_xor(v, 2); v += __shfl_xor(v, 4); return v;
#else
#define DPP_ADD(ctrl) v += __builtin_bit_cast(float, __builtin_amdgcn_update_dpp(0, __builtin_bit_cast(int, v), ctrl, 0xF, 0xF, true))
    DPP_ADD(0xB1); DPP_ADD(0x4E); DPP_ADD(0x141); return v;
#undef DPP_ADD
#endif
}
DI float row16_sum_(float v) {
#ifdef HIPEMU
    v += __shfl_xor(v, 1); v += __shfl_xor(v, 2); v += __shfl_xor(v, 4); v += __shfl_xor(v, 8); return v;
#else
#define DPP_ADD(ctrl) v += __builtin_bit_cast(float, __builtin_amdgcn_update_dpp(0, __builtin_bit_cast(int, v), ctrl, 0xF, 0xF, true))
    DPP_ADD(0xB1); DPP_ADD(0x4E); DPP_ADD(0x141); DPP_ADD(0x140); return v;
#undef DPP_ADD
#endif
}
DI void phase_mlstm_scan(Frame& F) {
    constexpr int NCM = TL / 64 > TC / 64 ? TL / 64 : TC / 64;
    LAS bf16* Qs = (LAS bf16*)F.lds;
    LAS bf16* Ks = Qs + 64 * ML_QS;
    LAS bf16* Kw = Ks + 64 * ML_QS;
    LAS bf16* Vt = Kw + 128 * ML_SS;
    LAS bf16* Ct = Vt + 64 * ML_SS;
    LAS bf16* Sp = Ct + 64 * ML_QS;
    LAS float* fa = (LAS float*)(Sp + 64 * ML_SS);
    LAS float* a_n = fa, *a_rs = fa + 128, *a_qn = fa + 256;
    LAS float* g_bc = fa + 320, *g_ib = g_bc + NCM * 64, *g_mc = g_ib + NCM * 64, *g_av = g_mc + NCM * 64, *g_wg = g_av + NCM * 64;
    LAS float* g_bl = g_wg + NCM * 64, *g_pml = g_bl + NCM, *g_m = g_pml + NCM, *g_dec = g_m + NCM + 1;
    const bf16* P = WSP(bf16, WS_MPROJ); const float* Gt = WSP(float, WS_GATES); bf16* HD_ = WSP(bf16, WS_HDIR);
    const int l15 = F.lane & 15, kq = F.lane >> 4; const float scale = 0.08838834764831845f;
    constexpr int I_LAT = BL * MH * 2 * 4, I_CTX = BC * MH * 2 * 4;
    for (int it = F.bx; it < I_LAT + I_CTX; it += F.G) {
        const bool lat = it < I_LAT; int r = lat ? it : it - I_LAT;
        const int dvq = r & 3; r >>= 2; const int dir = r & 1; r >>= 1; const int h = r % MH, b = r / MH;
        const int T = lat ? TL : TC, rowbase = lat ? MC + b * TL : b * TC, nc = T / 64;
        __syncthreads();
        for (int c = F.wave; c < nc; c += NWAVES) { const int s = F.lane, tau = 64 * c + s, t = dir ? T - 1 - tau : tau; const float* g = Gt + (size_t)(rowbase + t) * NGATE;
            const float ipre = g[(2 * dir) * MH + h], lf = log_sigmoidf_(g[(2 * dir + 1) * MH + h]);
            float bc = lf;
#pragma unroll
            for (int o = 1; o < 64; o <<= 1) { const float u = __shfl_up(bc, o); if (s >= o) bc += u; }
            const float ib = ipre - bc; float pm = ib;
#pragma unroll
            for (int o = 1; o < 64; o <<= 1) { const float u = __shfl_up(pm, o); if (s >= o) pm = fmaxf(pm, u); }
            g_bc[c * 64 + s] = bc; g_ib[c * 64 + s] = ib; g_mc[c * 64 + s] = pm;
            if (s == 63) { g_bl[c] = bc; g_pml[c] = pm; } }
        f32x4 Cacc[4];
#pragma unroll
        for (int dvt = 0; dvt < 4; ++dvt)
#pragma unroll
            for (int j = 0; j < 4; ++j) { const int dk = 16 * F.wave + 4 * kq + j, dv = dvq * 64 + 16 * dvt + l15;
                Cacc[dvt][j] = lat ? F.inp(I_MC)[((((size_t)b * 2 + dir) * MH + h) * MDK + dk) * MDV + dv] : 0.f; }
        if (F.tid < MDK) a_n[F.tid] = lat ? F.inp(I_MN)[(((size_t)b * 2 + dir) * MH + h) * MDK + F.tid] : 0.f;
#pragma unroll
        for (int dvt = 0; dvt < 4; ++dvt) { u32x2 w; w.x = pk2(Cacc[dvt][0], Cacc[dvt][1]); w.y = pk2(Cacc[dvt][2], Cacc[dvt][3]); *(LAS u32x2*)(Ct + (16 * dvt + l15) * ML_QS + 16 * F.wave + 4 * kq) = w; }
        __syncthreads();
        if (F.tid == 0) { float m = lat ? F.inp(I_MM)[((size_t)b * 2 + dir) * MH + h] : 0.f;
            for (int c = 0; c < nc; ++c) { g_m[c] = m; const float bl = g_bl[c], mn = bl + fmaxf(m, g_pml[c]); g_dec[c] = __expf(bl + m - mn); m = mn; }
            g_m[nc] = m; }
        __syncthreads();
        for (int i = F.tid; i < nc * 64; i += NTHR) { const int c = i >> 6; const float mprev = g_m[c], bc = g_bc[i], pm = g_mc[i];
            const float mcv = bc + fmaxf(mprev, pm); g_mc[i] = mcv; g_av[i] = __expf(bc + mprev - mcv); g_wg[i] = __expf(g_bl[c] + g_ib[i] - g_m[c + 1]); }
        u32x4 rq0, rq1, rk0, rk1, rv0;
#define ML_FETCH(c_) do { const int s_ = F.tid & 63, pc_ = F.tid >> 6; const int tau_ = 64 * (c_) + s_, t_ = dir ? T - 1 - tau_ : tau_; const bf16* prow_ = P + (size_t)(rowbase + t_) * MIN; \
            rq0 = *(const u32x4*)(prow_ + h * MDK + pc_ * 16); rq1 = *(const u32x4*)(prow_ + h * MDK + pc_ * 16 + 8); \
            rk0 = *(const u32x4*)(prow_ + MH * MDK + h * MDK + pc_ * 16); rk1 = *(const u32x4*)(prow_ + MH * MDK + h * MDK + pc_ * 16 + 8); \
            rv0 = *(const u32x4*)(prow_ + 2 * MH * MDK + h * MDV + dvq * 64 + pc_ * 8); } while (0)
        ML_FETCH(0);
        for (int c = 0; c < nc; ++c) {
            if (c > 0) { const float decay = g_dec[c - 1];
                if (F.tid < MDK) { float sm = 0.f;
#pragma unroll 8
                    for (int e = 0; e < 64; ++e) sm += bf2f(Kw[F.tid * ML_SS + e]);
                    a_n[F.tid] = decay * a_n[F.tid] + sm; }
#pragma unroll
                for (int dvt = 0; dvt < 4; ++dvt) { u32x2 w; w.x = pk2(Cacc[dvt][0], Cacc[dvt][1]); w.y = pk2(Cacc[dvt][2], Cacc[dvt][3]); *(LAS u32x2*)(Ct + (16 * dvt + l15) * ML_QS + 16 * F.wave + 4 * kq) = w; } }
            { const int s = F.tid & 63, pc = F.tid >> 6;
              *(LAS u32x4*)(Qs + s * ML_QS + pc * 16) = rq0; *(LAS u32x4*)(Qs + s * ML_QS + pc * 16 + 8) = rq1;
              *(LAS u32x4*)(Ks + s * ML_QS + pc * 16) = rk0; *(LAS u32x4*)(Ks + s * ML_QS + pc * 16 + 8) = rk1;
              const unsigned vw[4] = {rv0.x, rv0.y, rv0.z, rv0.w};
#pragma unroll
              for (int e = 0; e < 4; ++e) { Vt[(pc * 8 + 2 * e) * ML_SS + s] = (bf16)(vw[e] & 0xffffu); Vt[(pc * 8 + 2 * e + 1) * ML_SS + s] = (bf16)(vw[e] >> 16); } }
            if (c + 1 < nc) ML_FETCH(c + 1);
            __syncthreads();
            const LAS float* a_bcum = g_bc + c * 64, *a_ib = g_ib + c * 64, *a_mc = g_mc + c * 64, *a_av = g_av + c * 64, *a_wg = g_wg + c * 64;
            { const int s = F.tid & 63, pc = F.tid >> 6; const float wg = a_wg[s];
#pragma unroll
              for (int e = 0; e < 16; ++e) Kw[(pc * 16 + e) * ML_SS + s] = (bf16)f2bf(wg * bf2f(Ks[s * ML_QS + pc * 16 + e])); }
            { const int tt = F.wave & 3; float rsum[4] = {0.f, 0.f, 0.f, 0.f};
#pragma unroll
              for (int i = 0; i < 2; ++i) { const int st = 2 * (F.wave >> 2) + i; f32x4 acc = (f32x4){0.f, 0.f, 0.f, 0.f};
#pragma unroll
                  for (int ks = 0; ks < 4; ++ks) { const bf16x8 a = *(const LAS bf16x8*)(Qs + (tt * 16 + l15) * ML_QS + ks * 32 + kq * 8), bb = *(const LAS bf16x8*)(Ks + (st * 16 + l15) * ML_QS + ks * 32 + kq * 8);
                      acc = __builtin_amdgcn_mfma_f32_16x16x32_bf16(a, bb, acc, 0, 0, 0); }
                  const int s = st * 16 + l15; const float ibs = a_ib[s];
#pragma unroll
                  for (int j = 0; j < 4; ++j) { const int t = tt * 16 + kq * 4 + j; const float v = s <= t ? acc[j] * scale * __expf(a_bcum[t] - a_mc[t] + ibs) : 0.f;
                      const unsigned vb = f2bf(v); Sp[t * ML_SS + s] = (bf16)vb; rsum[j] += bf2f(vb); } }
#pragma unroll
              for (int j = 0; j < 4; ++j) { const float rs = row16_sum_(rsum[j]); if (l15 == 0) a_rs[(F.wave >> 2) * 64 + tt * 16 + kq * 4 + j] = rs; } }
            { const int t = 8 * F.wave + (F.lane >> 3), part = F.lane & 7; float qn = 0.f;
#pragma unroll
              for (int e = 0; e < 16; ++e) qn += bf2f(Qs[t * ML_QS + part * 16 + e]) * a_n[part * 16 + e];
              qn = oct_sum(qn); if (part == 0) a_qn[t] = qn; }
            __syncthreads();
            { const int tt = F.wave & 3;
#pragma unroll
              for (int i = 0; i < 2; ++i) { const int dvt = 2 * (F.wave >> 2) + i; f32x4 a1 = (f32x4){0.f, 0.f, 0.f, 0.f}, a2 = (f32x4){0.f, 0.f, 0.f, 0.f};
#pragma unroll
                  for (int ks = 0; ks < 2; ++ks) { const bf16x8 a = *(const LAS bf16x8*)(Sp + (tt * 16 + l15) * ML_SS + ks * 32 + kq * 8), bb = *(const LAS bf16x8*)(Vt + (dvt * 16 + l15) * ML_SS + ks * 32 + kq * 8);
                      a1 = __builtin_amdgcn_mfma_f32_16x16x32_bf16(a, bb, a1, 0, 0, 0); }
#pragma unroll
                  for (int ks = 0; ks < 4; ++ks) { const bf16x8 a = *(const LAS bf16x8*)(Qs + (tt * 16 + l15) * ML_QS + ks * 32 + kq * 8), bb = *(const LAS bf16x8*)(Ct + (dvt * 16 + l15) * ML_QS + ks * 32 + kq * 8);
                      a2 = __builtin_amdgcn_mfma_f32_16x16x32_bf16(a, bb, a2, 0, 0, 0); }
#pragma unroll
                  for (int j = 0; j < 4; ++j) { const int t = tt * 16 + kq * 4 + j; const float avs = a_av[t] * scale;
                      const float num = a1[j] + avs * a2[j], den = (a_rs[t] + a_rs[64 + t]) + avs * a_qn[t];
                      const int tau = 64 * c + t, tok = dir ? T - 1 - tau : tau;
                      HD_[((size_t)dir * M + rowbase + tok) * D + h * MDV + dvq * 64 + dvt * 16 + l15] = (bf16)f2bf(num / fmaxf(fabsf(den), __expf(-a_mc[t]))); } } }
            { const float decay = g_dec[c];
#pragma unroll
              for (int dvt = 0; dvt < 4; ++dvt) { Cacc[dvt] *= decay;
#pragma unroll
                  for (int ks = 0; ks < 2; ++ks) { const bf16x8 a = *(const LAS bf16x8*)(Kw + (16 * F.wave + l15) * ML_SS + ks * 32 + kq * 8), bb = *(const LAS bf16x8*)(Vt + (dvt * 16 + l15) * ML_SS + ks * 32 + kq * 8);
                      Cacc[dvt] = __builtin_amdgcn_mfma_f32_16x16x32_bf16(a, bb, Cacc[dvt], 0, 0, 0); } } }
            __syncthreads();
        }
#undef ML_FETCH
        { const float decay = g_dec[nc - 1];
          if (F.tid < MDK) { float sm = 0.f;
#pragma unroll 8
              for (int e = 0; e < 64; ++e) sm += bf2f(Kw[F.tid * ML_SS + e]);
              a_n[F.tid] = decay * a_n[F.tid] + sm; } }
        if (!lat) {
#pragma unroll
            for (int dvt = 0; dvt < 4; ++dvt)
#pragma unroll
                for (int j = 0; j < 4; ++j) { const int dk = 16 * F.wave + 4 * kq + j, dv = dvq * 64 + 16 * dvt + l15;
                    NT_ST(F.out + O_MC + ((((size_t)b * 2 + dir) * MH + h) * MDK + dk) * MDV + dv, Cacc[dvt][j]); }
            if (dvq == 0) { if (F.tid < MDK) F.out[O_MN + (((size_t)b * 2 + dir) * MH + h) * MDK + F.tid] = a_n[F.tid];
                if (F.tid == 0) F.out[O_MM + ((size_t)b * 2 + dir) * MH + h] = g_m[nc]; }
        }
    }
    __syncthreads();
}
DI void phase_mlstm_combine(Frame& F) {
    const int gw = F.bx * NWAVES + F.wave, NGW = F.G * NWAVES;
    const bf16* HD_ = WSP(bf16, WS_HDIR); const bf16* P = WSP(bf16, WS_MPROJ); bf16* OB = WSP(bf16, WS_OB); const float* on = F.inp(I_MON);
    for (int row = gw; row < M; row += NGW)
        for (int h = 0; h < MH; ++h) { const int c = h * MDV + 4 * F.lane;
            const u32x2 hf = *(const u32x2*)(HD_ + (size_t)row * D + c), hb = *(const u32x2*)(HD_ + ((size_t)M + row) * D + c);
            const f32x4 s = (f32x4){bflo(hf.x) + bflo(hb.x), bfhi(hf.x) + bfhi(hb.x), bflo(hf.y) + bflo(hb.y), bfhi(hf.y) + bfhi(hb.y)};
            const float rstd = 1.0f / sqrtf(wave_sum((s.x * s.x + s.y * s.y) + (s.z * s.z + s.w * s.w)) * (1.0f / MDV) + EPS);
            const f32x4 g = *(const f32x4*)(on + c); const u32x2 ow = *(const u32x2*)(P + (size_t)row * MIN + 2 * MH * MDK + D + c);
            u32x2 w; w.x = pk2(sigmoidf_(bflo(ow.x)) * s.x * rstd * g.x, sigmoidf_(bfhi(ow.x)) * s.y * rstd * g.y); w.y = pk2(sigmoidf_(bflo(ow.y)) * s.z * rstd * g.z, sigmoidf_(bfhi(ow.y)) * s.w * rstd * g.w);
            *(u32x2*)(OB + (size_t)row * D + c) = w; }
}

constexpr int RW_TB = 4;
DI float quad_sum(float x) {
#ifdef HIPEMU
    x += __shfl_xor(x, 1); x += __shfl_xor(x, 2); return x;
#else
    x += __builtin_bit_cast(float, __builtin_amdgcn_update_dpp(0, __builtin_bit_cast(int, x), 0xB1, 0xF, 0xF, true));
    x += __builtin_bit_cast(float, __builtin_amdgcn_update_dpp(0, __builtin_bit_cast(int, x), 0x4E, 0xF, 0xF, true));
    return x;
#endif
}
template <int NR> DI void rwkv_task(Frame& F, int task, bool lat) {
    LAS float* slab = (LAS float*)(F.lds + F.wave * (RW_TB * 6 * 64 * 4));
    const bf16* RKV = WSP(bf16, WS_RKV); const float* DEC = WSP(float, WS_DEC); const bf16* AG = WSP(bf16, WS_AG); bf16* YD = WSP(bf16, WS_YDIR);
    constexpr int NPART = 4 / NR;
    int r = task; const int part = r % NPART; r /= NPART; const int dir = r & 1; r >>= 1; const int h = r % RH, b = r / RH;
    const int T = lat ? TL : TC, rowbase = lat ? MC + b * TL : b * TC, col = h * 64 + F.lane;
    const int rgrp = F.lane >> 2, q = F.lane & 3, v0 = part * (16 * NR) + rgrp * NR;
    const float k_k = F.inp(I_RKK)[col], k_a = F.inp(I_RKA)[col];
    f32x2 S[NR][8];
#pragma unroll
    for (int i = 0; i < NR; ++i) {
        if (lat) { const float* sp = F.inp(I_RS) + ((((size_t)b * 2 + dir) * RH + h) * 64 + v0 + i) * 64 + q * 16;
#pragma unroll
            for (int k = 0; k < 4; ++k) { const f32x4 x = *(const f32x4*)(sp + 4 * k); S[i][2 * k] = (f32x2){x.x, x.y}; S[i][2 * k + 1] = (f32x2){x.z, x.w}; } }
        else {
#pragma unroll
            for (int k = 0; k < 8; ++k) S[i][k] = (f32x2){0.f, 0.f}; } }
    const bf16* Rp = RKV + (size_t)rowbase * D + col; const bf16* Kp = Rp + (size_t)M * D; const bf16* Vp = Kp + (size_t)M * D;
    const float* Wp = DEC + ((size_t)dir * M + rowbase) * D + col; const bf16* Ap = AG + ((size_t)dir * M + rowbase) * D + col;
    bf16* Yp = YD + ((size_t)dir * M + rowbase) * D + h * 64 + v0;
    float cr[RW_TB], ck[RW_TB], cv[RW_TB], cw[RW_TB], ca[RW_TB];
#pragma unroll
    for (int i = 0; i < RW_TB; ++i) { const int t = dir ? T - 1 - i : i; cr[i] = bf2f(Rp[(size_t)t * D]); ck[i] = bf2f(Kp[(size_t)t * D]); cv[i] = bf2f(Vp[(size_t)t * D]); cw[i] = Wp[(size_t)t * D]; ca[i] = bf2f(Ap[(size_t)t * D]); }
    for (int g0 = 0; g0 < T; g0 += RW_TB) {
        WSYNC();
#pragma unroll
        for (int i = 0; i < RW_TB; ++i) {
            const float kr = ck[i] * k_k; const float kk = kr * rsqrtf(fmaxf(wave_sum(kr * kr), 1e-24f));
            const float kd = ck[i] * (1.0f + (ca[i] - 1.0f) * k_a);
            LAS float* sl = slab + i * 384 + F.lane;
            sl[0] = kk; sl[64] = cw[i]; sl[128] = kk * ca[i]; sl[192] = kd; sl[256] = cr[i]; sl[320] = cv[i];
        }
        { const int gn = g0 + RW_TB < T ? g0 + RW_TB : g0;
#pragma unroll
          for (int i = 0; i < RW_TB; ++i) { const int tau = gn + i, t = dir ? T - 1 - tau : tau; cr[i] = bf2f(Rp[(size_t)t * D]); ck[i] = bf2f(Kp[(size_t)t * D]); cv[i] = bf2f(Vp[(size_t)t * D]); cw[i] = Wp[(size_t)t * D]; ca[i] = bf2f(Ap[(size_t)t * D]); } }
        WSYNC();
#pragma unroll 1
        for (int i = 0; i < RW_TB; ++i) {
            const int tau = g0 + i, t = dir ? T - 1 - tau : tau;
            const LAS float* sl = slab + i * 384 + q * 16;
            f32x4 xk[4], xw[4], xb[4], xd[4], xr[4];
#pragma unroll
            for (int k4 = 0; k4 < 4; ++k4) xk[k4] = *(const LAS f32x4*)(sl + 4 * k4);
            float vv[NR];
#pragma unroll
            for (int j = 0; j < NR; ++j) vv[j] = slab[i * 384 + 320 + v0 + j];
#pragma unroll
            for (int k4 = 0; k4 < 4; ++k4) { xw[k4] = *(const LAS f32x4*)(sl + 64 + 4 * k4); xb[k4] = *(const LAS f32x4*)(sl + 128 + 4 * k4); xd[k4] = *(const LAS f32x4*)(sl + 192 + 4 * k4); xr[k4] = *(const LAS f32x4*)(sl + 256 + 4 * k4); }
            float ys[NR];
#pragma unroll
            for (int j = 0; j < NR; ++j) {
                f32x2 sa2 = (f32x2){0.f, 0.f}, sb2 = (f32x2){0.f, 0.f};
#pragma unroll
                for (int k4 = 0; k4 < 4; ++k4) { sa2 += S[j][2 * k4] * (f32x2){xk[k4].x, xk[k4].y}; sb2 += S[j][2 * k4 + 1] * (f32x2){xk[k4].z, xk[k4].w}; }
                const f32x2 sc2 = sa2 + sb2; const float nsa = -quad_sum(sc2.x + sc2.y), vj = vv[j];
                f32x2 ya = (f32x2){0.f, 0.f}, yb = (f32x2){0.f, 0.f};
#pragma unroll
                for (int k4 = 0; k4 < 4; ++k4) {
                    const f32x2 wl = (f32x2){xw[k4].x, xw[k4].y}, wh = (f32x2){xw[k4].z, xw[k4].w}, bl = (f32x2){xb[k4].x, xb[k4].y}, bh = (f32x2){xb[k4].z, xb[k4].w};
                    const f32x2 dl = (f32x2){xd[k4].x, xd[k4].y}, dh = (f32x2){xd[k4].z, xd[k4].w}, rl = (f32x2){xr[k4].x, xr[k4].y}, rh = (f32x2){xr[k4].z, xr[k4].w};
                    S[j][2 * k4] = S[j][2 * k4] * wl + (bl * nsa + dl * vj); S[j][2 * k4 + 1] = S[j][2 * k4 + 1] * wh + (bh * nsa + dh * vj);
                    ya += S[j][2 * k4] * rl; yb += S[j][2 * k4 + 1] * rh; }
                const f32x2 yc = ya + yb; ys[j] = quad_sum(yc.x + yc.y);
            }
            if (q == 0) {
#pragma unroll
                for (int j = 0; j < NR; ++j) Yp[(size_t)t * D + j] = (bf16)f2bf(ys[j]); }
        }
    }
    if (!lat) {
#pragma unroll
        for (int i = 0; i < NR; ++i) { float* op = F.out + O_RS + ((((size_t)b * 2 + dir) * RH + h) * 64 + v0 + i) * 64 + q * 16;
#pragma unroll
            for (int k = 0; k < 4; ++k) NT_ST((f32x4*)(op + 4 * k), ((f32x4){S[i][2 * k].x, S[i][2 * k].y, S[i][2 * k + 1].x, S[i][2 * k + 1].y})); } }
    WSYNC();
}
#ifndef RW_NRC
#define RW_NRC 4
#endif
DI void phase_rwkv_scan(Frame& F) {
    const int gw = F.bx * NWAVES + F.wave, NGW = F.G * NWAVES;
    constexpr int T_LAT = BL * RH * 2 * 4, T_CTX = BC * RH * 2 * (4 / RW_NRC);
    const bool bal = (NGW == 2048 && T_LAT == 1024 && (T_CTX == 2048 || T_CTX == 4096));
    constexpr int CPW = T_CTX / 1024;
    const int n_lat = bal ? (F.wave < 4 ? 1 : 0) : (gw < T_LAT ? (T_LAT - 1 - gw) / NGW + 1 : 0);
    const int n_ctx = bal ? (F.wave < 4 ? 0 : CPW) : (gw < T_CTX ? (T_CTX - 1 - gw) / NGW + 1 : 0);
#ifndef HIPEMU
    if (bal && F.wave < 4) __builtin_amdgcn_s_setprio(2);
#endif
#pragma unroll 1
    for (int n = 0; n < n_lat + n_ctx; ++n) {
        if (n < n_lat) rwkv_task<1>(F, bal ? F.bx * 4 + F.wave : gw + n * NGW, true);
        else { const int m = n - n_lat; rwkv_task<RW_NRC>(F, bal ? (F.bx * 4 + (F.wave - 4)) * CPW + m : gw + m * NGW, false); }
    }
#ifndef HIPEMU
    __builtin_amdgcn_s_setprio(0);
#endif
}
DI float row16_sum(float v) {
#ifdef HIPEMU
    v += __shfl_xor(v, 1); v += __shfl_xor(v, 2); v += __shfl_xor(v, 4); v += __shfl_xor(v, 8); return v;
#else
#define DPP_ADD(ctrl) v += __builtin_bit_cast(float, __builtin_amdgcn_update_dpp(0, __builtin_bit_cast(int, v), ctrl, 0xF, 0xF, true))
    DPP_ADD(0xB1); DPP_ADD(0x4E); DPP_ADD(0x141); DPP_ADD(0x140); return v;
#undef DPP_ADD
#endif
}
DI f32x4 ld_bf4(const bf16* p) { const u32x2 w = *(const u32x2*)p; return (f32x4){bflo(w.x), bfhi(w.x), bflo(w.y), bfhi(w.y)}; }
DI void phase_rwkv_combine(Frame& F) {
    const int gw = F.bx * NWAVES + F.wave, NGW = F.G * NWAVES;
    const bf16* RKV = WSP(bf16, WS_RKV); const bf16* AG = WSP(bf16, WS_AG); const bf16* YD = WSP(bf16, WS_YDIR); bf16* OB = WSP(bf16, WS_OB);
    const float* lng = F.inp(I_RLNG); const float* lnb = F.inp(I_RLNB); const float* rk = F.inp(I_RRK); const float* kaw = F.inp(I_RKA);
    for (int row = gw; row < M; row += NGW)
#pragma unroll 2
        for (int c = 4 * F.lane; c < D; c += 256) { const size_t o = (size_t)row * D + c;
            const f32x4 y = ld_bf4(YD + o) + ld_bf4(YD + (size_t)M * D + o);
            const float mean = row16_sum((y.x + y.y) + (y.z + y.w)) * (1.0f / 64.0f); const f32x4 d = y - mean;
            const float var = row16_sum((d.x * d.x + d.y * d.y) + (d.z * d.z + d.w * d.w)) * (1.0f / 64.0f);
            const f32x4 yn = d * (1.0f / sqrtf(var + GN_EPS)) * *(const f32x4*)(lng + c) + *(const f32x4*)(lnb + c);
            const f32x4 rr = ld_bf4(RKV + o), kk = ld_bf4(RKV + (size_t)M * D + o), vv = ld_bf4(RKV + (size_t)2 * M * D + o), a0 = ld_bf4(AG + o), a1 = ld_bf4(AG + (size_t)M * D + o), g = ld_bf4(AG + (size_t)2 * M * D + o);
            const f32x4 ka = *(const f32x4*)(kaw + c); const f32x4 t = rr * kk * *(const f32x4*)(rk + c) * (((a0 - 1.0f) * ka + 1.0f) + ((a1 - 1.0f) * ka + 1.0f));
            const float bonus = row16_sum((t.x + t.y) + (t.z + t.w));
            const f32x4 out = (yn + vv * bonus) * g;
            u32x2 w; w.x = pk2(out.x, out.y); w.y = pk2(out.z, out.w); *(u32x2*)(OB + o) = w; }
}

constexpr int NPH = 1 + 9 * 8;
#ifdef HIPEMU
#define KERNEL_LDS() (emu_lds())
#else
#define KERNEL_LDS() ((LAS unsigned char*)lds_raw)
#endif
#define XN WSP(bf16, WS_XN)
#define OB WSP(bf16, WS_OB)
#define MOD WSP(float, WS_MOD)
#ifndef PH_MASK
#define PH_MASK 0xffffffffu
#endif
#define EN(g) (((PH_MASK) >> (g)) & 1u)
__global__ void __launch_bounds__(NTHR, 2) hybrid_fwd(Args args) {
#ifndef HIPEMU
    extern __shared__ __attribute__((aligned(16))) unsigned char lds_raw[];
#endif
    Frame F;
    F.lds = KERNEL_LDS();
    F.tid = threadIdx.x; F.lane = F.tid & 63; F.wave = __builtin_amdgcn_readfirstlane(F.tid >> 6); F.G = gridDim.x; F.bx = blockIdx.x;
#ifdef HIPEMU
    F.ap = &args;
#else
    F.ap = (ArgsP)__builtin_amdgcn_kernarg_segment_ptr();
#endif
    F.refresh();
    for (int u = F.tid; u < (LDS_BYTES - LDSCTL_OFF) / 4; u += NTHR) ((LAS unsigned*)(F.lds + LDSCTL_OFF))[u] = 0u;
    __syncthreads();
#ifndef HIPEMU
    XcdBarrier bar = xcd_barrier_post((unsigned*)(F.ws + WS_CTL) + CW_BAR, (volatile LAS unsigned*)(F.lds + MISC_OFF) + 8);
#else
    XcdBarrier bar{0};
#endif
    const int lo = F.ap->ph_lo, hi = F.ap->ph_hi; bool first = true;
#ifndef BAR_DUP
#define BAR_DUP 0
#endif
#define PH(id) if (lo <= (id) && (id) < hi && (first ? (first = false, true) : (xcd_barrier(bar), (BAR_DUP ? (xcd_barrier(bar), 0) : 0), true)) && (F.refresh(), true) && (PHMARK(id), true))
#ifdef HIPEMU
#define OPAQUE_S(x) do { } while (0)
#define PHMARK(id) 0
#else
#define OPAQUE_S(x) asm volatile("" : "+s"(x))
#define PHMARK(id) ({ asm volatile("; PHASE_MARK " #id); 0; })
#endif
#ifndef REP_MASK
#define REP_MASK 0u
#endif
#ifndef PROBE_PSKIP
#define PROBE_PSKIP 0
#endif
#ifndef PROBE_SAMEUNIT
#define PROBE_SAMEUNIT 0
#endif
#ifndef PROBE_HALFK
#define PROBE_HALFK 0
#endif
#ifndef PROBE_SKIPEPI
#define PROBE_SKIPEPI 0
#endif
#define NREP(g) ((((REP_MASK) >> (g)) & 1u) ? 2 : 1)
#define RP(g, id) if (EN(g)) PH(id) for (int rep = 0, nrep = opq(NREP(g)); rep < nrep; ++rep) if (rep == 0 || (xcd_barrier(bar), true))
#define SPLIT_CNT(id) ((unsigned*)(F.ws + WS_CTL + 65536) + (size_t)(id) * 2048)
#ifndef ALIGN_MASK
#define ALIGN_MASK 0xffffffffu
#endif
#ifndef SPLIT4_MASK
#define SPLIT4_MASK 0u
#endif
#define GEMM_SPLIT_T(EpiT, MapT, mapinit, ntK_, Einit, id, kind, fp8_) { OrderSplit<MapT> S{mapinit, ntK_, F.G, F.bx, (int)(((SPLIT4_MASK) >> (kind)) & 1u)}; EpiSplit<EpiT> E{Einit, WSP(float, WS_SLAB), SPLIT_CNT(id), S.nprod_per_unit(), rep ? PROBE_PSKIP : 0}; \
        pg8::gemm_phase<EpiSplit<EpiT>, OrderSplit<MapT>, ((ALIGN_MASK >> (kind)) & 1u) != 0, true, fp8_>(F.lds, g, S, E); }
#define GEMM_SPLIT(EpiT, MapT, mapinit, ntK_, Einit, id, kind) GEMM_SPLIT_T(EpiT, MapT, mapinit, ntK_, Einit, id, kind, false)
#define GEMM_RESID_T(a_off, b_off, K_, gate_idx, gs_, id, xfirst, fp8_) { pg8::Gemm g{WSP(bf16, a_off), WSP(bf16, b_off), M, D, K_}; \
        GEMM_SPLIT_T(EpiResid, MapSimple, (MapSimple{NM, D / 256, 0}), (K_) / 64, (EpiResid{F.out, MOD + (size_t)(gate_idx) * D, rep ? 0.0f : gs_, rep && PROBE_SKIPEPI, (xfirst) ? F.inp(I_XP) : nullptr, (xfirst) ? F.inp(I_XS) : nullptr}), id, 3, fp8_) }
#define GEMM_RESID(a_off, b_off, K_, gate_idx, gs_, id, xfirst) GEMM_RESID_T(a_off, b_off, K_, gate_idx, gs_, id, xfirst, false)
    RP(0, 0) { p0_prologue(F); }
    for (int hl = 0; hl < 8; ++hl) {
        const int layer = hl >> 1, j = hl & 1, base = 1 + 9 * hl;
        RP(1, base + 0) { phase_norm(F, layer, j ? 2 : 0, hl == 0, hl >= FFN_IN_FP8_FROM); }
        if (hl >= FFN_IN_FP8_FROM) { RP(2, base + 1) { pg8::Gemm g{XN, WSP(bf16, WS_WFI + (size_t)hl * SZ_WFI), M, 2 * DFF, D / 2}; GEMM_SPLIT_T(EpiSwiglu8, MapSimple, (MapSimple{NM, 2 * DFF / 256, 0}), D / 128, (EpiSwiglu8{WSP(bf16, WS_H), rep && PROBE_SKIPEPI}), base + 1, 2, true) } }
        else
        RP(2, base + 1) { pg8::Gemm g{XN, WSP(bf16, WS_WFI + (size_t)hl * SZ_WFI), M, 2 * DFF, D}; GEMM_SPLIT(EpiSwiglu, MapSimple, (MapSimple{NM, 2 * DFF / 256, rep && PROBE_SAMEUNIT}), (rep && PROBE_HALFK) ? D / 128 : D / 64, (EpiSwiglu{WSP(bf16, WS_H), rep && PROBE_SKIPEPI}), base + 1, 2) }
#if FFN_OUT_FP8
        RP(3, base + 2) GEMM_RESID_T(WS_H, WS_WFO + (size_t)hl * SZ_WFO, DFF / 2, layer * NCOND * NMOD + (j ? 8 : 2), 0.5f / WFO_SCALE, base + 2, hl == 0 && rep == 0, true)
#else
        RP(3, base + 2) GEMM_RESID(WS_H, WS_WFO + (size_t)hl * SZ_WFO, DFF, layer * NCOND * NMOD + (j ? 8 : 2), 0.5f, base + 2, hl == 0 && rep == 0)
#endif
        if (j) continue;
        const int kind = layer % 3, slot = layer / 3, g5 = layer * NCOND * NMOD + 5;
        if (kind == 0) {
            RP(4, base + 3) { phase_norm(F, layer, 1, false); }
            RP(5, base + 4) { pg8::Gemm g{XN, WSP(bf16, WS_WQKV + (size_t)slot * SZ_WQKV), M, QKVD, D}; GEMM_SPLIT(EpiBf16, MapSimple, (MapSimple{NM, QKVD / 256, 0}), D / 64, (EpiBf16{WSP(bf16, WS_QKV), QKVD}), base + 4, 5) }
            RP(6, base + 5) { phase_qknorm(F, slot); }
            RP(7, base + 6) { phase_attn(F, slot); }
            RP(8, base + 7) GEMM_RESID(WS_OB, WS_WAO + (size_t)slot * SZ_WDD, D, g5, 1.0f, base + 7, false)
        } else if (kind == 1) {
            RP(9, base + 3) { phase_norm(F, layer, 1, false); }
            RP(10, base + 4) { pg8::Gemm g{XN, WSP(bf16, WS_WMI), M, MING, D}; GEMM_SPLIT(EpiMlstmIn, MapSimple, (MapSimple{NM, MING / 256, 0}), D / 64, (EpiMlstmIn{WSP(bf16, WS_MPROJ), WSP(float, WS_GATES), F.inp(I_MBG)}), base + 4, 10) }
            RP(11, base + 5) { phase_mlstm_scan(F); }
            RP(12, base + 6) { phase_mlstm_combine(F); }
            RP(13, base + 7) GEMM_RESID(WS_OB, WS_WMO, D, g5, 1.0f, base + 7, false)
        } else {
            RP(14, base + 3) { phase_norm_rwkv(F, layer); }
            RP(15, base + 4) { pg8::Gemm g{XN, WSP(bf16, WS_WRK), 6 * M, 3 * D + 768, D}; GEMM_SPLIT(EpiRwkv1, MapRwkv1, (MapRwkv1{}), D / 64, (EpiRwkv1{WSP(bf16, WS_RKV), WSP(bf16, WS_LAB)}), base + 4, 15) }
            RP(16, base + 5) { int k2 = 256; OPAQUE_S(k2); pg8::Gemm g{WSP(bf16, WS_LAB), WSP(bf16, WS_WLB), 3 * M, 5 * D, k2}; GEMM_SPLIT(EpiRwkv2, MapRwkv2, (MapRwkv2{}), k2 / 64, (EpiRwkv2{WSP(float, WS_DEC), WSP(bf16, WS_AG), F.inp(I_RW0), F.inp(I_RA0)}), base + 5, 16) }
            RP(17, base + 6) { phase_rwkv_scan(F); }
            RP(18, base + 7) { phase_rwkv_combine(F); }
            RP(19, base + 8) GEMM_RESID(WS_OB, WS_WRO, D, g5, 1.0f, base + 8, false)
        }
    }
#undef PH
}

#ifndef MK_PER_PHASE
#define MK_PER_PHASE 0
#endif
extern "C" void kernel_launch(void* const* d_in, const int* in_sizes, int n_in, void* d_out, int out_size, void* d_ws, size_t ws_size, hipStream_t stream) {
    static int grid = 0;
    if (grid == 0) {
        if (n_in != N_IN || (size_t)out_size != O_END || ws_size < WS_END) { fprintf(stderr, "kernel_launch: unexpected sizes: n_in %d out %d ws %zu (need %zu)\n", n_in, out_size, ws_size, (size_t)WS_END); grid = -1; return; }
#ifndef HIPEMU
        int dev = 0, cus = 0, per_cu = 0;
        if (hipGetDevice(&dev) != hipSuccess || hipDeviceGetAttribute(&cus, hipDeviceAttributeMultiprocessorCount, dev) != hipSuccess) { grid = -1; return; }
        if (hipFuncSetAttribute((const void*)hybrid_fwd, hipFuncAttributeMaxDynamicSharedMemorySize, LDS_BYTES) != hipSuccess) { fprintf(stderr, "kernel_launch: hipFuncSetAttribute failed\n"); grid = -1; return; }
        if (hipOccupancyMaxActiveBlocksPerMultiprocessor(&per_cu, (const void*)hybrid_fwd, NTHR, LDS_BYTES) != hipSuccess || per_cu < 1) fprintf(stderr, "kernel_launch: occupancy query reports %d\n", per_cu);
        (void)hipGetLastError();
        grid = cus;
#else
        grid = EMU_GRID;
#endif
    }
    if (grid < 0) return;
    (void)hipMemsetAsync((char*)d_ws + WS_CTL, 0, CTL_ZERO_BYTES, stream);
    Args a{};
    for (int i = 0; i < N_IN; ++i) a.in[i] = (const float*)d_in[i];
    a.out = (float*)d_out; a.ws = (unsigned char*)d_ws;
#if MK_PER_PHASE
    for (int p = 0; p < NPH; ++p) { a.ph_lo = p; a.ph_hi = p + 1; hipLaunchKernelGGL(hybrid_fwd, dim3(grid), dim3(NTHR), LDS_BYTES, stream, a);
#ifdef HIPEMU
        emu_after_phase(p, (float*)d_out);
#endif
    }
#else
    a.ph_lo = 0; a.ph_hi = NPH;
    hipLaunchKernelGGL(hybrid_fwd, dim3(grid), dim3(NTHR), LDS_BYTES, stream, a);
#endif
}
```
